# Optimizing an MI355X kernel written in HIP

```python
import jax, jax.numpy as jnp
from jax import lax
import numpy as np

D_MODEL = 1024
BATCH = 16
SEQ = 2048
DEPTH = 1

N_Q_HEADS = 8
N_KV_HEADS = 2
HEAD_DIM = 128
Q_GROUP = N_Q_HEADS // N_KV_HEADS
ROPE_THETA = 10000.0
Q_BLOCK = 128
GRID_W = 64
LRU_WIDTH = 1024
LRU_BLOCKS = 8
LRU_BLOCK_DIM = LRU_WIDTH // LRU_BLOCKS
CONV_WIDTH = 4
LRU_C = 8.0
N_EXPERTS = 32
TOP_K = 4
D_EXPERT = 1024
SWIGLU_LIMIT = 7.0
SWIGLU_ALPHA = 1.702
MOE_BLOCK = 256
PLE_DIM = 256
EPS = 1e-6

Q_W = N_Q_HEADS * HEAD_DIM
KV_W = N_KV_HEADS * HEAD_DIM
IN_SPLITS = (Q_W, KV_W, KV_W, LRU_WIDTH, LRU_WIDTH, D_MODEL, D_MODEL)
IN_WIDTH = Q_W + 2 * KV_W + 2 * LRU_WIDTH + 2 * D_MODEL

kernel_name = "hybrid_gqa_rglru_moe_ple_encoder"


def rms_norm(x, g):
    xf = x.astype(jnp.float32)
    y = xf * lax.rsqrt(jnp.mean(xf * xf, axis=-1, keepdims=True) + EPS)
    return (y * g.astype(jnp.float32)).astype(x.dtype)


def axial_rope_tables(seq_len):
    rows = seq_len // GRID_W
    row_ids = jnp.repeat(jnp.arange(rows), GRID_W).astype(jnp.float32)
    col_ids = jnp.tile(jnp.arange(GRID_W), rows).astype(jnp.float32)
    axis_dim = HEAD_DIM // 2
    inv_freq = ROPE_THETA ** (-jnp.arange(0, axis_dim, 2, dtype=jnp.float32) / axis_dim)
    ang_r = row_ids[:, None] * inv_freq[None, :]
    ang_c = col_ids[:, None] * inv_freq[None, :]
    return (jnp.cos(ang_r), jnp.sin(ang_r), jnp.cos(ang_c), jnp.sin(ang_c))


def rope_rotate_half(x, cos, sin):
    x1, x2 = jnp.split(x, 2, axis=-1)
    c = cos[:, None, :]
    s = sin[:, None, :]
    return jnp.concatenate([x1 * c - x2 * s, x2 * c + x1 * s], axis=-1).astype(x.dtype)


def apply_axial_rope(x, tables):
    cr, sr, cc, sc = tables
    x_row, x_col = jnp.split(x, 2, axis=-1)
    return jnp.concatenate([rope_rotate_half(x_row, cr, sr), rope_rotate_half(x_col, cc, sc)], axis=-1)


def blocked_gqa(q, k, v):
    B, S = q.shape[0], q.shape[1]
    n_blk = S // Q_BLOCK
    qb = q.reshape(B, n_blk, Q_BLOCK, N_KV_HEADS, Q_GROUP, HEAD_DIM).transpose(1, 0, 2, 3, 4, 5)
    scale = HEAD_DIM ** -0.5

    def one_block(q_blk):
        s = jnp.einsum('bqkgd,bskd->bkgqs', q_blk, k, preferred_element_type=jnp.float32) * scale
        pr = jax.nn.softmax(s, axis=-1)
        return jnp.einsum('bkgqs,bskd->bqkgd', pr.astype(v.dtype), v)

    ob = lax.map(one_block, qb)
    return ob.transpose(1, 0, 2, 3, 4, 5).reshape(B, S, Q_W)


def centred_depthwise_conv(x, w, b):
    left = CONV_WIDTH // 2
    right = CONV_WIDTH - 1 - left
    y = lax.conv_general_dilated(
        x, w[:, None, :].astype(x.dtype), window_strides=(1,), padding=[(left, right)],
        dimension_numbers=('NWC', 'WIO', 'NWC'), feature_group_count=x.shape[-1])
    return y + b


def block_diag_linear(x, w, b):
    B, S, C = x.shape
    xb = x.reshape(B, S, LRU_BLOCKS, LRU_BLOCK_DIM)
    return jnp.einsum('bsnd,nde->bsne', xb, w).reshape(B, S, C) + b


def linear_recurrence(a, b):
    def combine(c1, c2):
        a1, b1 = c1
        a2, b2 = c2
        return a1 * a2, a2 * b1 + b2
    _, h = lax.associative_scan(combine, (a, b), axis=1)
    return h


def rg_lru(x, w_a, b_a, w_i, b_i, lam, reverse):
    xf = x.astype(jnp.float32)
    r = jax.nn.sigmoid(block_diag_linear(x, w_a, b_a).astype(jnp.float32))
    i = jax.nn.sigmoid(block_diag_linear(x, w_i, b_i).astype(jnp.float32))
    log_a = -LRU_C * r * jax.nn.softplus(-lam.astype(jnp.float32))
    a = jnp.exp(log_a)
    mult = jnp.sqrt(-jnp.expm1(2.0 * log_a))
    bt = mult * i * xf
    if reverse:
        h = jnp.flip(linear_recurrence(jnp.flip(a, 1), jnp.flip(bt, 1)), 1)
    else:
        h = linear_recurrence(a, bt)
    return h.astype(x.dtype)


def hybrid_mixer(h, rope, g_mix, w_in, q_norm, k_norm, conv_w, conv_b,
                 lru_wa, lru_ba, lru_wi, lru_bi, lru_lam, w_attn_br, w_lru_br, w_out):
    B, S, _ = h.shape
    u = rms_norm(h, g_mix)
    z = u @ w_in
    points = np.cumsum(IN_SPLITS)[:-1].tolist()
    q, k, v, xr, xg, ga, gr = jnp.split(z, points, axis=-1)
    q = q.reshape(B, S, N_Q_HEADS, HEAD_DIM)
    k = k.reshape(B, S, N_KV_HEADS, HEAD_DIM)
    v = v.reshape(B, S, N_KV_HEADS, HEAD_DIM)
    q = apply_axial_rope(rms_norm(q, q_norm), rope)
    k = apply_axial_rope(rms_norm(k, k_norm), rope)
    y_attn = blocked_gqa(q, k, v) @ w_attn_br
    c = centred_depthwise_conv(xr, conv_w, conv_b)
    h_fwd = rg_lru(c, lru_wa[0], lru_ba[0], lru_wi[0], lru_bi[0], lru_lam[0], reverse=False)
    h_bwd = rg_lru(c, lru_wa[1], lru_ba[1], lru_wi[1], lru_bi[1], lru_lam[1], reverse=True)
    y_lru = ((h_fwd + h_bwd) * jax.nn.gelu(xg, approximate=True)) @ w_lru_br
    merged = jax.nn.sigmoid(ga) * y_attn + jax.nn.sigmoid(gr) * y_lru
    return merged @ w_out


def moe_ffn(h, g_moe, w_router, b_router, w_gu, b_gu, w_dn, b_dn):
    B, S, D = h.shape
    T = B * S
    TK = T * TOP_K
    u = rms_norm(h, g_moe).reshape(T, D)
    logits = (u @ w_router + b_router).astype(jnp.float32)
    top_val, top_idx = lax.top_k(logits, TOP_K)
    gates = jax.nn.softmax(top_val, axis=-1)
    e_flat = top_idx.reshape(-1).astype(jnp.int32)
    tok_flat = jnp.arange(TK, dtype=jnp.int32) // TOP_K
    g_flat = gates.reshape(-1)
    order = jnp.argsort(e_flat)
    e_sorted = e_flat[order]
    counts = jnp.zeros((N_EXPERTS,), jnp.int32).at[e_flat].add(1)
    padded = ((counts + MOE_BLOCK - 1) // MOE_BLOCK) * MOE_BLOCK
    start = jnp.cumsum(counts) - counts
    pad_end = jnp.cumsum(padded)
    pad_start = pad_end - padded
    dest = pad_start[e_sorted] + (jnp.arange(TK, dtype=jnp.int32) - start[e_sorted])
    cap = TK + N_EXPERTS * MOE_BLOCK
    n_blocks = cap // MOE_BLOCK
    slot_tok = jnp.zeros((cap,), jnp.int32).at[dest].set(tok_flat[order])
    slot_gate = jnp.zeros((cap,), jnp.float32).at[dest].set(g_flat[order])
    blk_start = jnp.arange(n_blocks, dtype=jnp.int32) * MOE_BLOCK
    blk_exp = jnp.minimum(jnp.sum(blk_start[:, None] >= pad_end[None, :], axis=1), N_EXPERTS - 1)
    xs = u[slot_tok].reshape(n_blocks, MOE_BLOCK, D)

    def expert_block(args):
        xb, e = args
        hu = xb @ w_gu[e] + b_gu[e]
        gate, up = jnp.split(hu, 2, axis=-1)
        gate = jnp.minimum(gate, SWIGLU_LIMIT)
        up = jnp.clip(up, -SWIGLU_LIMIT, SWIGLU_LIMIT)
        act = gate * jax.nn.sigmoid(SWIGLU_ALPHA * gate)
        return ((up + 1.0) * act) @ w_dn[e] + b_dn[e]

    ys = lax.map(expert_block, (xs, blk_exp)).reshape(cap, D)
    out = jnp.zeros((T, D), ys.dtype).at[slot_tok].add(ys * slot_gate[:, None].astype(ys.dtype))
    return out.reshape(B, S, D)


def setup_inputs(seed: int = 0) -> dict:
    key = jax.random.key(seed)
    ks = jax.random.split(key, 32)
    L, D, E, F = DEPTH, D_MODEL, N_EXPERTS, D_EXPERT

    def nrm(k, shape, scale):
        return jax.random.normal(k, shape, jnp.float32) * scale

    def gain(k, shape):
        return 1.0 + 0.05 * jax.random.normal(k, shape, jnp.float32)

    a_c = jax.random.uniform(ks[12], (L, 2, LRU_WIDTH), jnp.float32, 0.9, 0.999)
    s = a_c ** (1.0 / LRU_C)
    lam = jnp.log(s) - jnp.log1p(-s)
    return {
        "x": nrm(ks[0], (BATCH, SEQ, D), 1.0),
        "p": nrm(ks[1], (DEPTH, BATCH, SEQ, PLE_DIM), 1.0),
        "g_mix": gain(ks[2], (L, D)),
        "w_in": nrm(ks[3], (L, D, IN_WIDTH), D ** -0.5),
        "q_norm": gain(ks[4], (L, HEAD_DIM)),
        "k_norm": gain(ks[5], (L, HEAD_DIM)),
        "conv_w": nrm(ks[6], (L, CONV_WIDTH, LRU_WIDTH), CONV_WIDTH ** -0.5),
        "conv_b": nrm(ks[7], (L, LRU_WIDTH), 0.01),
        "lru_wa": nrm(ks[8], (L, 2, LRU_BLOCKS, LRU_BLOCK_DIM, LRU_BLOCK_DIM), LRU_BLOCK_DIM ** -0.5),
        "lru_ba": nrm(ks[9], (L, 2, LRU_WIDTH), 0.01),
        "lru_wi": nrm(ks[10], (L, 2, LRU_BLOCKS, LRU_BLOCK_DIM, LRU_BLOCK_DIM), LRU_BLOCK_DIM ** -0.5),
        "lru_bi": nrm(ks[11], (L, 2, LRU_WIDTH), 0.01),
        "lru_lam": lam,
        "w_attn_br": nrm(ks[13], (L, Q_W, D), Q_W ** -0.5),
        "w_lru_br": nrm(ks[14], (L, LRU_WIDTH, D), LRU_WIDTH ** -0.5),
        "w_out": nrm(ks[15], (L, D, D), D ** -0.5),
        "g_moe": gain(ks[16], (L, D)),
        "w_router": nrm(ks[17], (L, D, E), D ** -0.5),
        "b_router": nrm(ks[18], (L, E), 0.01),
        "w_gu": nrm(ks[19], (L, E, D, 2 * F), D ** -0.5),
        "b_gu": nrm(ks[20], (L, E, 2 * F), 0.01),
        "w_dn": nrm(ks[21], (L, E, F, D), F ** -0.5),
        "b_dn": nrm(ks[22], (L, E, D), 0.01),
        "g_ple": gain(ks[23], (L, D)),
        "w_ple_gate": nrm(ks[24], (L, D, D), D ** -0.5),
        "w_ple_proj": nrm(ks[25], (L, PLE_DIM, D), PLE_DIM ** -0.5),
    }


def reference(x, p, g_mix, w_in, q_norm, k_norm, conv_w, conv_b, lru_wa, lru_ba, lru_wi, lru_bi,
              lru_lam, w_attn_br, w_lru_br, w_out, g_moe, w_router, b_router, w_gu, b_gu, w_dn, b_dn,
              g_ple, w_ple_gate, w_ple_proj):
    S = x.shape[1]
    rope = axial_rope_tables(S)
    h = x
    for l in range(DEPTH):
        h = h + hybrid_mixer(h, rope, g_mix[l], w_in[l], q_norm[l], k_norm[l], conv_w[l], conv_b[l],
                             lru_wa[l], lru_ba[l], lru_wi[l], lru_bi[l], lru_lam[l],
                             w_attn_br[l], w_lru_br[l], w_out[l])
        h = h + moe_ffn(h, g_moe[l], w_router[l], b_router[l], w_gu[l], b_gu[l], w_dn[l], b_dn[l])
        u = rms_norm(h, g_ple[l])
        h = h + jax.nn.sigmoid(u @ w_ple_gate[l]) * (p[l] @ w_ple_proj[l])
    return h
```

```cpp
#include <hip/hip_runtime.h>
#include <cstdio>
#include <cstdint>
#include <cmath>

#ifndef MK_N_LAUNCHES
#define MK_N_LAUNCHES 1
#endif

#define GAS __attribute__((address_space(1)))
#define LAS __attribute__((address_space(3)))
typedef unsigned short bf16;
typedef unsigned short bf16_t;
typedef short bf16x8 __attribute__((ext_vector_type(8)));
typedef short s16x4 __attribute__((ext_vector_type(4)));
typedef float f32x4 __attribute__((ext_vector_type(4)));
typedef float f32x2 __attribute__((ext_vector_type(2)));
typedef float f32x16 __attribute__((ext_vector_type(16)));
typedef unsigned u32x4 __attribute__((ext_vector_type(4)));
typedef unsigned u32x2 __attribute__((ext_vector_type(2)));
typedef GAS unsigned gu32;

constexpr int D_MODEL = 1024, BATCH = 16, SEQ = 2048, T = BATCH * SEQ;
constexpr int NQH = 8, NKVH = 2, HD = 128, QW = NQH * HD, KVW = NKVH * HD;
constexpr int LRU_W = 1024, LRU_NB = 8, LRU_BD = 128;
constexpr int NE = 32, TOPK = 4, DEXP = 1024, PLE = 256;
constexpr int IN_W = QW + 2 * KVW + 2 * LRU_W + 2 * D_MODEL;
constexpr float EPS = 1e-6f;
constexpr int TK = T * TOPK;
constexpr int CAP = TK + NE * 256;
constexpr int LIST_CAP = T;

constexpr size_t MiB = 1u << 20;
constexpr size_t WS_CTL = 0, CTL_ZERO_BYTES = 64 * 1024;
constexpr size_t WS_RSTD1 = 512 * 1024;
constexpr size_t WS_RSTD2 = WS_RSTD1 + 128 * 1024;
constexpr size_t WS_RW = WS_RSTD2 + 128 * 1024;
constexpr size_t WS_LIST = 1 * MiB;
constexpr size_t WS_GATES = 5 * MiB;
constexpr size_t WS_STOK = WS_GATES + 512 * 1024;
constexpr size_t WS_SSCALE = WS_STOK + 640 * 1024;
constexpr size_t WS_SGATE = WS_SSCALE + 640 * 1024;
constexpr size_t WS_WIN = 8 * MiB;
constexpr size_t WS_WGU = 19 * MiB;
constexpr size_t WS_WDN = 147 * MiB;
constexpr size_t WS_WABR = 211 * MiB, WS_WLBR = 213 * MiB, WS_WOUT = 215 * MiB, WS_WPG = 217 * MiB, WS_WPP = 219 * MiB;
constexpr size_t WS_PP = 221 * MiB;
constexpr size_t WS_H1 = 285 * MiB;
constexpr size_t WS_H1B = 413 * MiB;
constexpr size_t WS_S = 477 * MiB;
constexpr size_t WS_Q = WS_S;
constexpr size_t WS_K = WS_Q + 64 * MiB;
constexpr size_t WS_V = WS_K + 16 * MiB;
constexpr size_t WS_XR = WS_V + 16 * MiB;
constexpr size_t WS_XG = WS_XR + 64 * MiB;
constexpr size_t WS_GA = WS_XG + 64 * MiB;
constexpr size_t WS_GR = WS_GA + 64 * MiB;
constexpr size_t WS_U1 = WS_GR + 64 * MiB;
constexpr size_t WS_PB = WS_U1 + 64 * MiB;
constexpr size_t WS_MRG = WS_PB + 16 * MiB;
constexpr size_t WS_S_END1 = WS_MRG + 64 * MiB;
constexpr size_t WS_XGATH = WS_S;
constexpr size_t WS_ACT = WS_S + 272 * MiB;
constexpr size_t WS_END = WS_ACT + 272 * MiB;
static_assert(WS_S_END1 <= 1024 * MiB && WS_END <= 1024 * MiB, "workspace map must fit 1 GiB");
static_assert(WS_SGATE + 640 * 1024 <= WS_WIN && (size_t)CAP * 4 <= 640 * 1024, "meta region");
constexpr int CW_CNT = 64;
constexpr int CW_BAR = 1024;

constexpr int LDS_BYTES = 147456;
constexpr int LDS_CTL_OFF = 143360;
constexpr int LDS_TAB_OFF = 139264;

__device__ __forceinline__ unsigned f2bf(float f) { unsigned u = __builtin_bit_cast(unsigned, f); return (u + 0x7fffu + ((u >> 16) & 1u)) >> 16; }
__device__ __forceinline__ unsigned pk2(float lo, float hi) { return f2bf(lo) | (f2bf(hi) << 16); }
__device__ __forceinline__ float bf2f(unsigned short h) { return __builtin_bit_cast(float, (unsigned)h << 16); }
__device__ __forceinline__ float bflo(unsigned w) { return __builtin_bit_cast(float, w << 16); }
__device__ __forceinline__ float bfhi(unsigned w) { return __builtin_bit_cast(float, w & 0xffff0000u); }
__device__ __forceinline__ unsigned cvt_pk_bf16(float lo, float hi) { unsigned r; asm volatile("v_cvt_pk_bf16_f32 %0, %1, %2" : "=v"(r) : "v"(lo), "v"(hi)); return r; }
__device__ __forceinline__ float sigmoidf_(float x) { return __builtin_amdgcn_rcpf(1.0f + __builtin_amdgcn_exp2f(-1.4426950408889634f * x)); }
__device__ __forceinline__ float gelu_tanh_(float x) { const float u = 1.5957691216057308f * (x + 0.044715f * x * x * x); return x * sigmoidf_(u); }
__device__ __forceinline__ float wave_sum(float v) {
#pragma unroll
    for (int o = 1; o < 64; o <<= 1) v += __shfl_xor(v, o);
    return v;
}
#define LDS_WAIT() asm volatile("s_waitcnt lgkmcnt(0)" ::: "memory")
#define VM_WAIT() asm volatile("s_waitcnt vmcnt(0)" ::: "memory")
#define RLX_AGENT __ATOMIC_RELAXED, __HIP_MEMORY_SCOPE_AGENT

namespace pg8 {
#define PG8_LAS __attribute__((address_space(3)))
constexpr int BM = 256, BK = 64, HALF = 128, HTB = HALF * BK * 2, STAGE_BYTES = 8 * HTB, NXCD = 8, WGM = 8;
__host__ __device__ __forceinline__ int lds_byte(int r, int c) { const int st = (r >> 4) * 2 + (c >> 5), rr = r & 15, cc = c & 31, ob = rr * 64 + cc * 2; return st * 1024 + (ob ^ (((ob >> 9) & 1) << 5)); }
__host__ __device__ __forceinline__ void stage_rc(int b, int& R, int& C) { const int st = b / 1024, sb = b % 1024, swz = sb ^ (((sb >> 9) & 1) << 5); R = (st >> 1) * 16 + swz / 64; C = (st & 1) * 32 + (swz % 64) / 2; }
__host__ __device__ __forceinline__ int perm32(int rho) { const int n = rho >> 4, i = rho & 15; return 8 * (i >> 2) + 4 * n + (i & 3); }

struct Unit { int pm, pn; };
struct Gemm { const bf16_t* A; const bf16_t* Bt; int M, N, K; };

struct StaticOrder {
    int nM, nN, nwg, G, c; const char* A; const char* B; size_t tstep;
    __device__ void init(const Gemm& g, int G_, int c_) { nM = g.M / BM; nN = g.N / BM; nwg = nM * nN; G = G_; c = c_; A = (const char*)g.A; B = (const char*)g.Bt; tstep = (size_t)BM * g.K * 2; }
    __device__ bool next(int i, Unit& u) const {
        const long L = (long)i * G + c; if (L >= nwg) return false;
        int wgid = (int)L; { const int q = nwg / NXCD, r = nwg % NXCD, xcd = wgid % NXCD, off = wgid / NXCD; wgid = (xcd < r ? xcd * (q + 1) : r * (q + 1) + (xcd - r) * q) + off; }
        const int nig = WGM * nN, gid = wgid / nig, fm = gid * WGM, gsz = (nM - fm) < WGM ? (nM - fm) : WGM;
        u.pm = fm + ((wgid % nig) % gsz); u.pn = (wgid % nig) / gsz; return true;
    }
    __device__ __forceinline__ const char* a_ptr(const Unit& u) const { return A + (size_t)u.pm * tstep; }
    __device__ __forceinline__ const char* b_ptr(const Unit& u) const { return B + (size_t)u.pn * tstep; }
};
struct MoeOrder : StaticOrder {
    const PG8_LAS int* t2e; size_t estride;
    __device__ void init_moe(const Gemm& g, int nMdyn, int G_, int c_, const PG8_LAS int* t2e_, size_t estride_) { init(g, G_, c_); nM = nMdyn; nwg = nM * nN; t2e = t2e_; estride = estride_; }
    __device__ __forceinline__ const char* b_ptr(const Unit& u) const { return B + (size_t)t2e[u.pm] * estride + (size_t)u.pn * tstep; }
};

template <class Epi, class Sched, bool ALIGN_EPI = true>
__device__ __forceinline__ void gemm_phase(PG8_LAS unsigned char* lds, const Gemm g, const Sched& S, const Epi& E) {
    const int tid = threadIdx.x, wid = __builtin_amdgcn_readfirstlane(tid >> 6), lane = tid & 63, wr = wid >> 2, wc = wid & 3, fr = lane & 15, fq = lane >> 4;
    const int K = g.K, nt = K / BK;
    unsigned voffA[2], voffB[2];
#pragma unroll
    for (int i = 0; i < 2; ++i) { int R, C; stage_rc(tid * 16 + i * 8192, R, C); const int Rb = Epi::PERM ? ((R & ~31) + perm32(R & 31)) : R;
        voffA[i] = (unsigned)(R * K + C) * 2u; voffB[i] = (unsigned)(Rb * K + C) * 2u; }
    const size_t kstep = (size_t)(BK * 2);
    const size_t hstep = (size_t)HALF * K * 2;
    const unsigned ldsw = (unsigned)wid * 1024u;
    const int aoff = lds_byte(wr * 64 + fr, fq * 8), boff = lds_byte(wc * 32 + fr, fq * 8);
#define PG8_SA(b, h) (((b) * 2 + (h)) * HTB)
#define PG8_SB(b, h) ((4 + (b) * 2 + (h)) * HTB)
#define PG8_STAGE(bufoff, gbase, voff) do { _Pragma("unroll") for (int _i = 0; _i < 2; ++_i) \
        __builtin_amdgcn_global_load_lds((const unsigned*)((const char*)(gbase) + (voff)[_i]), (PG8_LAS unsigned*)(lds + (bufoff) + ldsw + _i * 8192), 16, 0, 0); } while (0)
#define PG8_LDA(dst, b, h) do { _Pragma("unroll") for (int m = 0; m < 4; ++m) _Pragma("unroll") for (int k = 0; k < 2; ++k) dst[m][k] = *(const PG8_LAS bf16x8*)(lds + PG8_SA(b, h) + aoff + m * 2048 + k * 1024); } while (0)
#define PG8_LDB(dst, b, h) do { _Pragma("unroll") for (int n = 0; n < 2; ++n) _Pragma("unroll") for (int k = 0; k < 2; ++k) dst[n][k] = *(const PG8_LAS bf16x8*)(lds + PG8_SB(b, h) + boff + n * 2048 + k * 1024); } while (0)
#define PG8_MMA(ai, bj, At, Bt) do { __builtin_amdgcn_s_setprio(1); _Pragma("unroll") for (int m = 0; m < 4; ++m) _Pragma("unroll") for (int n = 0; n < 2; ++n) _Pragma("unroll") for (int k = 0; k < 2; ++k) \
        acc[ai][bj][m][n] = __builtin_amdgcn_mfma_f32_16x16x32_bf16(Bt[n][k], At[m][k], acc[ai][bj][m][n], 0, 0, 0); __builtin_amdgcn_s_setprio(0); } while (0)
#define PG8_WAIT_V(n) asm volatile("s_waitcnt vmcnt(" #n ")" ::: "memory")
#define PG8_WAIT_L(n) asm volatile("s_waitcnt lgkmcnt(" #n ")" ::: "memory")
#define PG8_BAR __builtin_amdgcn_s_barrier()
#define PG8_SCHED __builtin_amdgcn_sched_barrier(0)
    Unit cur, nxt; int ui = 0;
    if (!S.next(0, cur)) return;
    f32x4 acc[2][2][4][2];
#pragma unroll
    for (int a = 0; a < 2; ++a)
#pragma unroll
        for (int b = 0; b < 2; ++b)
#pragma unroll
            for (int m = 0; m < 4; ++m)
#pragma unroll
                for (int n = 0; n < 2; ++n) acc[a][b][m][n] = (f32x4){0.f, 0.f, 0.f, 0.f};
    bf16x8 At[4][2], B0[2][2], B1[2][2];
    const char* cA = S.a_ptr(cur); const char* cB = S.b_ptr(cur);
    PG8_STAGE(PG8_SB(0, 0), cB, voffB); PG8_STAGE(PG8_SB(0, 1), cB + hstep, voffB); PG8_STAGE(PG8_SA(0, 0), cA, voffA); PG8_STAGE(PG8_SA(0, 1), cA + hstep, voffA);
    if (wr == 1) PG8_BAR;
    PG8_WAIT_V(2); PG8_BAR;
    PG8_STAGE(PG8_SB(1, 0), cB + kstep, voffB); PG8_STAGE(PG8_SA(1, 0), cA + kstep, voffA); PG8_STAGE(PG8_SB(1, 1), cB + hstep + kstep, voffB);
    PG8_WAIT_V(6); PG8_BAR;
    for (;;) {
        const bool has_next = S.next(ui + 1, nxt);
        const char* nA = has_next ? S.a_ptr(nxt) : cA; const char* nB = has_next ? S.b_ptr(nxt) : cB;
        for (int t = 0; t < nt; t += 2) {
            const bool last = (t == nt - 2);
            const char* a1 = cA + (size_t)(t + 1) * kstep;
            const char* a2 = last ? nA : cA + (size_t)(t + 2) * kstep; const char* b2 = last ? nB : cB + (size_t)(t + 2) * kstep;
            const char* a3 = a2 + kstep; const char* b3 = b2 + kstep;
            PG8_LDB(B0, 0, 0); PG8_LDB(B1, 0, 1); PG8_SCHED; PG8_LDA(At, 0, 0); PG8_STAGE(PG8_SA(1, 1), a1 + hstep, voffA);
            PG8_WAIT_V(8); PG8_WAIT_L(0); PG8_BAR; PG8_MMA(0, 0, At, B0); PG8_MMA(0, 1, At, B1); PG8_BAR; PG8_SCHED;
            PG8_LDA(At, 0, 1); PG8_STAGE(PG8_SB(0, 0), b2, voffB); PG8_STAGE(PG8_SB(0, 1), b2 + hstep, voffB); PG8_STAGE(PG8_SA(0, 0), a2, voffA);
            PG8_WAIT_V(8); PG8_WAIT_L(0); PG8_BAR; PG8_MMA(1, 0, At, B0); PG8_MMA(1, 1, At, B1); PG8_BAR; PG8_SCHED;
            PG8_LDB(B0, 1, 0); PG8_LDB(B1, 1, 1); PG8_SCHED; PG8_LDA(At, 1, 0); PG8_STAGE(PG8_SA(0, 1), a2 + hstep, voffA);
            PG8_WAIT_V(8); PG8_WAIT_L(0); PG8_BAR; PG8_MMA(0, 0, At, B0); PG8_MMA(0, 1, At, B1); PG8_BAR; PG8_SCHED;
            PG8_LDA(At, 1, 1); PG8_STAGE(PG8_SB(1, 0), b3, voffB); PG8_STAGE(PG8_SB(1, 1), b3 + hstep, voffB); PG8_STAGE(PG8_SA(1, 0), a3, voffA);
            PG8_WAIT_V(8); PG8_WAIT_L(0); PG8_BAR; PG8_MMA(1, 0, At, B0); PG8_MMA(1, 1, At, B1); PG8_BAR; PG8_SCHED;
        }
        if constexpr (ALIGN_EPI) { if (wr == 0) PG8_BAR; }
        E(acc, cur, wr, wc, fr, fq);
        if (!has_next) break;
#pragma unroll
        for (int a = 0; a < 2; ++a)
#pragma unroll
            for (int b = 0; b < 2; ++b)
#pragma unroll
                for (int m = 0; m < 4; ++m)
#pragma unroll
                    for (int n = 0; n < 2; ++n) acc[a][b][m][n] = (f32x4){0.f, 0.f, 0.f, 0.f};
        cur = nxt; cA = nA; cB = nB; ++ui;
        if constexpr (ALIGN_EPI) { if (wr == 1) PG8_BAR; }
    }
    PG8_WAIT_V(0);
    if constexpr (!ALIGN_EPI) { if (wr == 0) PG8_BAR; }
    PG8_BAR;
#undef PG8_SA
#undef PG8_SB
#undef PG8_STAGE
#undef PG8_LDA
#undef PG8_LDB
#undef PG8_MMA
#undef PG8_WAIT_V
#undef PG8_WAIT_L
#undef PG8_BAR
#undef PG8_SCHED
}

typedef f32x4 Acc[2][2][4][2];
struct EpiInProj {
    static constexpr bool PERM = true;
    bf16_t *Q, *Kb, *Vb, *XR, *XG, *GA, *GR;
    __device__ __forceinline__ void operator()(const Acc& acc, const Unit& u, int wr, int wc, int fr, int fq) const {
        const int pn = u.pn; bf16_t* base; int ldc, colt, act;
        if (pn < 4) { base = Q; ldc = 1024; colt = pn * 256; act = 0; }
        else if (pn == 4) { base = Kb; ldc = 256; colt = 0; act = 0; }
        else if (pn == 5) { base = Vb; ldc = 256; colt = 0; act = 0; }
        else if (pn < 10) { base = XR; ldc = 1024; colt = (pn - 6) * 256; act = 0; }
        else if (pn < 14) { base = XG; ldc = 1024; colt = (pn - 10) * 256; act = 1; }
        else if (pn < 18) { base = GA; ldc = 1024; colt = (pn - 14) * 256; act = 2; }
        else { base = GR; ldc = 1024; colt = (pn - 18) * 256; act = 2; }
        const int row0 = u.pm * BM + wr * 64 + fr, col0 = colt + wc * 32 + 8 * fq;
#pragma unroll
        for (int ai = 0; ai < 2; ++ai)
#pragma unroll
            for (int m = 0; m < 4; ++m) { bf16_t* rowp = base + (size_t)(row0 + ai * HALF + m * 16) * ldc + col0;
#pragma unroll
                for (int bj = 0; bj < 2; ++bj) { f32x4 v0 = acc[ai][bj][m][0], v1 = acc[ai][bj][m][1];
                    if (act == 1) {
#pragma unroll
                        for (int e = 0; e < 4; ++e) { v0[e] = gelu_tanh_(v0[e]); v1[e] = gelu_tanh_(v1[e]); } }
                    else if (act == 2) {
#pragma unroll
                        for (int e = 0; e < 4; ++e) { v0[e] = sigmoidf_(v0[e]); v1[e] = sigmoidf_(v1[e]); } }
                    u32x4 w; w.x = cvt_pk_bf16(v0[0], v0[1]); w.y = cvt_pk_bf16(v0[2], v0[3]); w.z = cvt_pk_bf16(v1[0], v1[1]); w.w = cvt_pk_bf16(v1[2], v1[3]);
                    *(u32x4*)(rowp + bj * HALF) = w; } }
    }
};
struct EpiBf16 {
    static constexpr bool PERM = true;
    bf16_t* O; int ldc;
    __device__ __forceinline__ void operator()(const Acc& acc, const Unit& u, int wr, int wc, int fr, int fq) const {
        const int row0 = u.pm * BM + wr * 64 + fr, col0 = u.pn * BM + wc * 32 + 8 * fq;
#pragma unroll
        for (int ai = 0; ai < 2; ++ai)
#pragma unroll
            for (int m = 0; m < 4; ++m) { bf16_t* rowp = O + (size_t)(row0 + ai * HALF + m * 16) * ldc + col0;
#pragma unroll
                for (int bj = 0; bj < 2; ++bj) { const f32x4 v0 = acc[ai][bj][m][0], v1 = acc[ai][bj][m][1];
                    u32x4 w; w.x = cvt_pk_bf16(v0[0], v0[1]); w.y = cvt_pk_bf16(v0[2], v0[3]); w.z = cvt_pk_bf16(v1[0], v1[1]); w.w = cvt_pk_bf16(v1[2], v1[3]);
                    *(u32x4*)(rowp + bj * HALF) = w; } }
    }
};
template <int MODE> struct EpiGate {
    static constexpr bool PERM = true;
    const bf16_t* G; const bf16_t* P; bf16_t* O;
    __device__ __forceinline__ void operator()(const Acc& acc, const Unit& u, int wr, int wc, int fr, int fq) const {
        const int row0 = u.pm * BM + wr * 64 + fr, col0 = u.pn * BM + wc * 32 + 8 * fq;
#pragma unroll
        for (int ai = 0; ai < 2; ++ai)
#pragma unroll
            for (int m = 0; m < 4; ++m) { const size_t ro = (size_t)(row0 + ai * HALF + m * 16) * 1024 + col0;
#pragma unroll
                for (int bj = 0; bj < 2; ++bj) { const f32x4 v0 = acc[ai][bj][m][0], v1 = acc[ai][bj][m][1];
                    const u32x4 g = *(const u32x4*)(G + ro + bj * HALF);
                    float o[8];
                    o[0] = bflo(g.x) * v0[0]; o[1] = bfhi(g.x) * v0[1]; o[2] = bflo(g.y) * v0[2]; o[3] = bfhi(g.y) * v0[3];
                    o[4] = bflo(g.z) * v1[0]; o[5] = bfhi(g.z) * v1[1]; o[6] = bflo(g.w) * v1[2]; o[7] = bfhi(g.w) * v1[3];
                    if (MODE == 1) { const u32x4 p = *(const u32x4*)(P + ro + bj * HALF);
                        o[0] += bflo(p.x); o[1] += bfhi(p.x); o[2] += bflo(p.y); o[3] += bfhi(p.y); o[4] += bflo(p.z); o[5] += bfhi(p.z); o[6] += bflo(p.w); o[7] += bfhi(p.w); }
                    u32x4 w; w.x = cvt_pk_bf16(o[0], o[1]); w.y = cvt_pk_bf16(o[2], o[3]); w.z = cvt_pk_bf16(o[4], o[5]); w.w = cvt_pk_bf16(o[6], o[7]);
                    *(u32x4*)(O + ro + bj * HALF) = w; } }
    }
};
struct EpiResid {
    static constexpr bool PERM = false;
    const float* X; float* H; bf16_t* HB;
    __device__ __forceinline__ void operator()(const Acc& acc, const Unit& u, int wr, int wc, int fr, int fq) const {
        const int row0 = u.pm * BM + wr * 64 + fr, col0 = u.pn * BM + wc * 32 + 4 * fq;
#pragma unroll
        for (int ai = 0; ai < 2; ++ai)
#pragma unroll
            for (int m = 0; m < 4; ++m) { const size_t ro = (size_t)(row0 + ai * HALF + m * 16) * 1024 + col0;
#pragma unroll
                for (int bj = 0; bj < 2; ++bj)
#pragma unroll
                    for (int n = 0; n < 2; ++n) { const size_t o = ro + bj * HALF + n * 16; const f32x4 xv = *(const f32x4*)(X + o); const f32x4 h = xv + acc[ai][bj][m][n];
                        *(f32x4*)(H + o) = h; u32x2 w; w.x = cvt_pk_bf16(h[0], h[1]); w.y = cvt_pk_bf16(h[2], h[3]); *(u32x2*)(HB + o) = w; } }
    }
};
struct EpiSwiglu {
    static constexpr bool PERM = true;
    const PG8_LAS int* t2e; const float* bgu; const float* sscale; bf16_t* ACT;
    __device__ __forceinline__ void operator()(const Acc& acc, const Unit& u, int wr, int wc, int fr, int fq) const {
        const int e = t2e[u.pm]; const int row0 = u.pm * BM + wr * 64 + fr, j0 = u.pn * 128 + wc * 32 + 8 * fq;
        const float* bg = bgu + (size_t)e * 2048 + j0; const float* bu = bg + 1024;
        const f32x4 bg0 = *(const f32x4*)bg, bg1 = *(const f32x4*)(bg + 4), bu0 = *(const f32x4*)bu, bu1 = *(const f32x4*)(bu + 4);
#pragma unroll
        for (int ai = 0; ai < 2; ++ai)
#pragma unroll
            for (int m = 0; m < 4; ++m) { const int row = row0 + ai * HALF + m * 16; const float sc = sscale[row];
                float o[8];
#pragma unroll
                for (int n = 0; n < 2; ++n)
#pragma unroll
                    for (int q = 0; q < 4; ++q) { float gt = acc[ai][0][m][n][q] * sc + (n ? bg1[q] : bg0[q]); float up = acc[ai][1][m][n][q] * sc + (n ? bu1[q] : bu0[q]);
                        gt = fminf(gt, 7.0f); up = fminf(fmaxf(up, -7.0f), 7.0f); o[n * 4 + q] = (up + 1.0f) * (gt * sigmoidf_(1.702f * gt)); }
                u32x4 w; w.x = cvt_pk_bf16(o[0], o[1]); w.y = cvt_pk_bf16(o[2], o[3]); w.z = cvt_pk_bf16(o[4], o[5]); w.w = cvt_pk_bf16(o[6], o[7]);
                *(u32x4*)(ACT + (size_t)row * 1024 + j0) = w; }
    }
};
struct EpiDown {
    static constexpr bool PERM = true;
    const PG8_LAS int* t2e; const float* bdn; const float* sgate; const int* stok; bf16_t* Y;
    __device__ __forceinline__ void operator()(const Acc& acc, const Unit& u, int wr, int wc, int fr, int fq) const {
        const int e = t2e[u.pm]; const int row0 = u.pm * BM + wr * 64 + fr, col0 = u.pn * BM + wc * 32 + 8 * fq;
        f32x4 bv[2][2];
#pragma unroll
        for (int bj = 0; bj < 2; ++bj)
#pragma unroll
            for (int n = 0; n < 2; ++n) bv[bj][n] = *(const f32x4*)(bdn + (size_t)e * 1024 + col0 + bj * HALF + 4 * n);
#pragma unroll
        for (int ai = 0; ai < 2; ++ai)
#pragma unroll
            for (int m = 0; m < 4; ++m) { const int row = row0 + ai * HALF + m * 16; const int tk = stok[row]; const float gt = sgate[row];
                if (tk >= 0) { bf16_t* rowp = Y + (size_t)tk * 1024 + col0;
#pragma unroll
                    for (int bj = 0; bj < 2; ++bj) { const f32x4 v0 = (acc[ai][bj][m][0] + bv[bj][0]) * gt, v1 = (acc[ai][bj][m][1] + bv[bj][1]) * gt;
                        u32x4 w; w.x = cvt_pk_bf16(v0[0], v0[1]); w.y = cvt_pk_bf16(v0[2], v0[3]); w.z = cvt_pk_bf16(v1[0], v1[1]); w.w = cvt_pk_bf16(v1[2], v1[3]);
                        *(u32x4*)(rowp + bj * HALF) = w; } } }
    }
};
struct EpiPle {
    static constexpr bool PERM = false;
    float* OUT; const float* rstd; const bf16_t* PP;
    __device__ __forceinline__ void operator()(const Acc& acc, const Unit& u, int wr, int wc, int fr, int fq) const {
        const int row0 = u.pm * BM + wr * 64 + fr, col0 = u.pn * BM + wc * 32 + 4 * fq;
#pragma unroll
        for (int ai = 0; ai < 2; ++ai)
#pragma unroll
            for (int m = 0; m < 4; ++m) { const int row = row0 + ai * HALF + m * 16; const size_t ro = (size_t)row * 1024 + col0; const float rs = rstd[row];
#pragma unroll
                for (int bj = 0; bj < 2; ++bj)
#pragma unroll
                    for (int n = 0; n < 2; ++n) { const size_t o = ro + bj * HALF + n * 16; const f32x4 h = *(const f32x4*)(OUT + o); const u32x2 p = *(const u32x2*)(PP + o); const f32x4 a = acc[ai][bj][m][n];
                        f32x4 r; r[0] = h[0] + sigmoidf_(a[0] * rs) * bflo(p.x); r[1] = h[1] + sigmoidf_(a[1] * rs) * bfhi(p.x); r[2] = h[2] + sigmoidf_(a[2] * rs) * bflo(p.y); r[3] = h[3] + sigmoidf_(a[3] * rs) * bfhi(p.y);
                        *(f32x4*)(OUT + o) = r; } }
    }
};
}

namespace attn {
constexpr int D = 128, NW = 8, QBLK = 32, KVBLK = 64;
constexpr float SCALE = 0.088388347648318440f;
constexpr float THR = 8.f;
constexpr int LDQ = 1024, LDK = 256, LDO = 1024;
constexpr size_t SHM_V = KVBLK * D * 2, SHM_K = KVBLK * D * 2, SHM_ATTN = 2 * SHM_V + 2 * SHM_K + NW * 64 * 4;
#define KSWZ(row, colB) ((row) * 256 + ((colB) ^ (((row) & 7) << 4)))
#define SBAR() __builtin_amdgcn_sched_barrier(0)
__device__ __forceinline__ int crow(int r, int hi) { return (r & 3) + 8 * (r >> 2) + 4 * hi; }
__device__ __forceinline__ unsigned cvtpk(float lo, float hi) { unsigned r; asm volatile("v_cvt_pk_bf16_f32 %0, %1, %2" : "=v"(r) : "v"(lo), "v"(hi)); return r; }
__device__ __forceinline__ void partialSM(f32x16& p0, f32x16& p1, float& m_reg, float& mn, float& alpha) {
  constexpr float C = SCALE * 1.4426950408889634f;
  float pmax = p0[0]; for (int r = 1; r < 16; ++r) pmax = fmaxf(pmax, p0[r]); for (int r = 0; r < 16; ++r) pmax = fmaxf(pmax, p1[r]);
  { auto rr = __builtin_amdgcn_permlane32_swap(__float_as_uint(pmax), __float_as_uint(pmax), false, false);
    pmax = fmaxf(__uint_as_float(rr[0]), __uint_as_float(rr[1])); }
  if (__builtin_expect(__all(pmax - m_reg <= THR / SCALE), 1)) { mn = m_reg; alpha = 1.f; }
  else { mn = fmaxf(m_reg, pmax); alpha = __builtin_amdgcn_exp2f((m_reg - mn) * C); m_reg = mn; }
  float mnC = -mn * C;
  for (int r = 0; r < 16; ++r) p0[r] = fmaf(p0[r], C, mnC); for (int r = 0; r < 16; ++r) p1[r] = fmaf(p1[r], C, mnC);
  for (int r = 0; r < 16; ++r) p0[r] = __builtin_amdgcn_exp2f(p0[r]);
}
__device__ __forceinline__ void finishSM(f32x16& p0, f32x16& p1, float alpha, float& l_reg, bf16x8& pa0, bf16x8& pa1, bf16x8& pa2, bf16x8& pa3) {
  for (int r = 0; r < 16; ++r) p1[r] = __builtin_amdgcn_exp2f(p1[r]);
  float ps = 0; for (int r = 0; r < 16; ++r) ps += p0[r]; for (int r = 0; r < 16; ++r) ps += p1[r];
  { auto rr = __builtin_amdgcn_permlane32_swap(__float_as_uint(ps), __float_as_uint(ps), false, false);
    ps = __uint_as_float(rr[0]) + __uint_as_float(rr[1]); }
  l_reg = l_reg * alpha + ps;
#define PK4(P, BASE, OUT) do { unsigned a0 = cvtpk(P[BASE + 0], P[BASE + 1]), a1 = cvtpk(P[BASE + 2], P[BASE + 3]);   \
    unsigned b0 = cvtpk(P[BASE + 4], P[BASE + 5]), b1 = cvtpk(P[BASE + 6], P[BASE + 7]);                              \
    auto r0 = __builtin_amdgcn_permlane32_swap(a0, b0, false, false); auto r1 = __builtin_amdgcn_permlane32_swap(a1, b1, false, false); \
    u32x4 w = {r0[0], r1[0], r0[1], r1[1]}; OUT = *reinterpret_cast<bf16x8*>(&w); } while (0)
  PK4(p0, 0, pa0); PK4(p0, 8, pa1); PK4(p1, 0, pa2); PK4(p1, 8, pa3);
#undef PK4
}
__device__ __forceinline__ void qkt(f32x16& p0, f32x16& p1, const bf16* Ks, const bf16x8* qr, int r32, int hi) {
  p0 = f32x16{}; p1 = f32x16{};
  for (int d0 = 0; d0 < 8; ++d0) { int cb = (d0 * 16 + hi * 8) * 2;
    bf16x8 b0 = *reinterpret_cast<const bf16x8*>((const char*)Ks + KSWZ(r32, cb));
    bf16x8 b1 = *reinterpret_cast<const bf16x8*>((const char*)Ks + KSWZ(32 + r32, cb));
    p0 = __builtin_amdgcn_mfma_f32_32x32x16_bf16(b0, qr[d0], p0, 0, 0, 0);
    p1 = __builtin_amdgcn_mfma_f32_32x32x16_bf16(b1, qr[d0], p1, 0, 0, 0); }
}
__device__ __forceinline__ int v_st(int k, int c) { const int kk = (k & ~0xC) | ((k & 4) << 1) | ((k & 8) >> 1); return ((kk >> 3) * 4 + (c >> 5)) * 512 + ((kk & 7) * 32 + (c & 31)) * 2; }
__device__ __forceinline__ int v_rd_base(int lane) { return ((lane & 3) << 3) | (((lane >> 2) & 3) << 6) | (((lane >> 4) & 1) << 5) | (((lane >> 5) & 1) << 8); }
constexpr int v_rd_off(int d0, int ks, int half) { return d0 * 512 + ks * 4096 + half * 2048; }
template <int OFF> __device__ __forceinline__ s16x4 tr_read(int vb) {
  s16x4 r; asm volatile("ds_read_b64_tr_b16 %0, %1 offset:%2" : "=&v"(r) : "v"(vb), "i"(OFF) : "memory"); return r;
}
template <int D0> __device__ __forceinline__ void pv_one(f32x16& od, int vb, bf16x8 pa0, bf16x8 pa1, bf16x8 pa2, bf16x8 pa3) {
  const s16x4 l0 = tr_read<v_rd_off(D0, 0, 0)>(vb), h0 = tr_read<v_rd_off(D0, 0, 1)>(vb), l1 = tr_read<v_rd_off(D0, 1, 0)>(vb), h1 = tr_read<v_rd_off(D0, 1, 1)>(vb);
  const s16x4 l2 = tr_read<v_rd_off(D0, 2, 0)>(vb), h2 = tr_read<v_rd_off(D0, 2, 1)>(vb), l3 = tr_read<v_rd_off(D0, 3, 0)>(vb), h3 = tr_read<v_rd_off(D0, 3, 1)>(vb);
  asm volatile("s_waitcnt lgkmcnt(0)" ::: "memory"); SBAR();
#define PK(L, H) (bf16x8){L[0], L[1], L[2], L[3], H[0], H[1], H[2], H[3]}
  od = __builtin_amdgcn_mfma_f32_32x32x16_bf16(pa0, PK(l0, h0), od, 0, 0, 0);
  od = __builtin_amdgcn_mfma_f32_32x32x16_bf16(pa1, PK(l1, h1), od, 0, 0, 0);
  od = __builtin_amdgcn_mfma_f32_32x32x16_bf16(pa2, PK(l2, h2), od, 0, 0, 0);
  od = __builtin_amdgcn_mfma_f32_32x32x16_bf16(pa3, PK(l3, h3), od, 0, 0, 0);
#undef PK
}
__device__ __forceinline__ void pv_d0(f32x16* o, int vb, bf16x8 pa0, bf16x8 pa1, bf16x8 pa2, bf16x8 pa3) {
  pv_one<0>(o[0], vb, pa0, pa1, pa2, pa3); pv_one<1>(o[1], vb, pa0, pa1, pa2, pa3); pv_one<2>(o[2], vb, pa0, pa1, pa2, pa3); pv_one<3>(o[3], vb, pa0, pa1, pa2, pa3);
}
__device__ __forceinline__ void attn_dense_body(const bf16* Qb, const bf16* __restrict__ Kh, const bf16* __restrict__ Vh, bf16* Ob, int seq, char* lds) {
  const int tid = threadIdx.x, wid = tid >> 6, lane = tid & 63, r32 = lane & 31, hi = lane >> 5;
  bf16* V_lds = (bf16*)lds; bf16* K_lds = (bf16*)(lds + 2 * SHM_V);
  float* ws = (float*)(lds + 2 * SHM_V + 2 * SHM_K) + wid * 64; float* li_l = ws; float* al_l = ws + 32;
  float m_reg = -1e30f, l_reg = 0; f32x16 o[4] = {}; bf16x8 qr[8];
  const bf16* Qw = Qb + (long)(wid * QBLK + r32) * LDQ + hi * 8;
#pragma unroll
  for (int d0 = 0; d0 < 8; ++d0) qr[d0] = *reinterpret_cast<const bf16x8*>(Qw + d0 * 16);
  const int sr = tid >> 4, sc = (tid & 15) * 8, vst0 = v_st(sr, sc), vst1 = v_st(32 + sr, sc);
  const int vb0 = (int)(uintptr_t)V_lds + v_rd_base(lane);
  struct { bf16x8 vs0, vs1, ks0, ks1; } sr_[2];
#define SLOAD(i, k0) do { sr_[i].vs0 = *reinterpret_cast<const bf16x8*>(&Vh[(long)((k0) + sr) * LDK + sc]); sr_[i].vs1 = *reinterpret_cast<const bf16x8*>(&Vh[(long)((k0) + 32 + sr) * LDK + sc]); \
    sr_[i].ks0 = *reinterpret_cast<const bf16x8*>(&Kh[(long)((k0) + sr) * LDK + sc]); sr_[i].ks1 = *reinterpret_cast<const bf16x8*>(&Kh[(long)((k0) + 32 + sr) * LDK + sc]); } while (0)
#define SWRITE(b, i) do { *(bf16x8*)((char*)V_lds + (b) * SHM_V + vst0) = sr_[i].vs0;          \
    *(bf16x8*)((char*)V_lds + (b) * SHM_V + vst1) = sr_[i].vs1; int kc = sc * 2;               \
    *(bf16x8*)((char*)K_lds + (b) * SHM_K + KSWZ(sr, kc)) = sr_[i].ks0;                       \
    *(bf16x8*)((char*)K_lds + (b) * SHM_K + KSWZ(32 + sr, kc)) = sr_[i].ks1; } while (0)
#define SWAIT() asm volatile("s_waitcnt vmcnt(4)" ::: "memory")
#define RESC(a) do { if (__any((a) < 1.f)) { if (hi == 0) al_l[r32] = (a); asm volatile("s_waitcnt lgkmcnt(0)" ::: "memory"); \
    for (int d = 0; d < 4; ++d) for (int r = 0; r < 16; ++r) o[d][r] *= al_l[crow(r, hi)]; } } while (0)
  f32x16 pA0, pA1, pB0, pB1; float mnA, mnB, alA, alB; bf16x8 pa0, pa1, pa2, pa3; const int NT = seq / KVBLK;
  constexpr int SE = 0, SO = 1;
  SLOAD(SE, 0); asm volatile("s_waitcnt vmcnt(0)" ::: "memory"); SWRITE(0, SE); __syncthreads();
  qkt(pA0, pA1, K_lds, qr, r32, hi); partialSM(pA0, pA1, m_reg, mnA, alA);
  SLOAD(SO, KVBLK); if (2 < NT) SLOAD(SE, 2 * KVBLK);
  SWAIT(); SWRITE(1, SO); __syncthreads();
  for (int j = 1; j + 1 < NT; j += 2) {
    SBAR(); qkt(pB0, pB1, (bf16*)((char*)K_lds + SHM_K), qr, r32, hi);
    finishSM(pA0, pA1, alA, l_reg, pa0, pa1, pa2, pa3); SBAR();
    SLOAD(SO, (j + 2) * KVBLK); SBAR();
    pv_d0(o, vb0, pa0, pa1, pa2, pa3); partialSM(pB0, pB1, m_reg, mnB, alB);
    __syncthreads(); SWAIT(); SWRITE(0, SE);
    RESC(alB); __syncthreads();
    SBAR(); qkt(pA0, pA1, K_lds, qr, r32, hi);
    finishSM(pB0, pB1, alB, l_reg, pa0, pa1, pa2, pa3); SBAR();
    if (j + 3 < NT) SLOAD(SE, (j + 3) * KVBLK); SBAR();
    pv_d0(o, vb0 + (int)SHM_V, pa0, pa1, pa2, pa3); partialSM(pA0, pA1, m_reg, mnA, alA);
    __syncthreads(); SWAIT(); SWRITE(1, SO);
    RESC(alA); __syncthreads();
  }
  SBAR(); qkt(pB0, pB1, (bf16*)((char*)K_lds + SHM_K), qr, r32, hi);
  finishSM(pA0, pA1, alA, l_reg, pa0, pa1, pa2, pa3); SBAR();
  pv_d0(o, vb0, pa0, pa1, pa2, pa3); partialSM(pB0, pB1, m_reg, mnB, alB);
  __syncthreads(); RESC(alB);
  finishSM(pB0, pB1, alB, l_reg, pa0, pa1, pa2, pa3); SBAR();
  pv_d0(o, vb0 + (int)SHM_V, pa0, pa1, pa2, pa3);
  if (hi == 0) li_l[r32] = l_reg; asm volatile("s_waitcnt lgkmcnt(0)" ::: "memory");
  float rli[16];
#pragma unroll
  for (int r = 0; r < 16; ++r) rli[r] = __builtin_amdgcn_rcpf(li_l[crow(r, hi)]);
  bf16* Ow = Ob + (long)(wid * QBLK) * LDO;
#pragma unroll
  for (int r = 0; r < 16; ++r) { int orow = crow(r, hi);
    for (int d0 = 0; d0 < 4; ++d0) Ow[(long)orow * LDO + d0 * 32 + r32] = (bf16)f2bf(o[d0][r] * rli[r]); }
  __syncthreads();
#undef SLOAD
#undef SWRITE
#undef SWAIT
#undef RESC
}
}

#define XB_TMO      128
#define XB_XCNT(j)  (256  + 64 * (j))
#define XB_XSUB(j)  (1280 + 64 * (j))
#define XB_XGEN(j)  (2304 + 64 * (j))
#define XB_TOP      3328
#define XB_TOPGEN   3392
#define XCD_BAR_WORDS 3456
#define XB_SPIN_CAP (1u << 18)
__device__ __forceinline__ unsigned xb_ld(unsigned* p)              { return __hip_atomic_load(p, __ATOMIC_RELAXED, __HIP_MEMORY_SCOPE_AGENT); }
__device__ __forceinline__ unsigned xb_add(unsigned* p, unsigned v) { return __hip_atomic_fetch_add(p, v, __ATOMIC_RELAXED, __HIP_MEMORY_SCOPE_AGENT); }
__device__ __forceinline__ unsigned xb_xcc_id() { return (unsigned)__builtin_amdgcn_s_getreg((3 << 11) | 20) & 0xFu; }
#define XB_SPIN(cond, bar) do { unsigned _sp = 0; while (cond) { __builtin_amdgcn_s_sleep(1); \
    if ((++_sp & 255u) == 0u) { if (xb_ld(&(bar)[XB_TMO])) break; if (_sp > XB_SPIN_CAP) { atomicAdd(&(bar)[XB_TMO], 1u); break; } } } } while (0)
struct XcdBarrier { unsigned* bar; unsigned x; volatile LAS unsigned* st; };
__device__ __forceinline__ XcdBarrier xcd_barrier_post(unsigned* bar, volatile LAS unsigned* st) {
    XcdBarrier b; b.bar = bar; b.x = xb_xcc_id(); b.st = st;
    if (threadIdx.x == 0) (void)xb_add(&bar[XB_XCNT(b.x)], 1u);
    return b;
}
__device__ __forceinline__ void xcd_barrier_complete(unsigned* bar, unsigned x, unsigned& nloc, unsigned& nx) {
    const unsigned G = gridDim.x * gridDim.y * gridDim.z;
    unsigned sum, cnt, mine, sp = 0u;
    for (;;) {
        sum = 0u; cnt = 0u; mine = 0u;
#pragma unroll
        for (unsigned j = 0; j < 16; ++j) { const unsigned c = xb_ld(&bar[XB_XCNT(j)]); sum += c; cnt += (c > 0u) ? 1u : 0u; mine = (j == x) ? c : mine; }
        if (sum == G) break;
        __builtin_amdgcn_s_sleep(1);
        if ((++sp & 255u) == 0u) { if (xb_ld(&bar[XB_TMO])) break; if (sp > XB_SPIN_CAP) { atomicAdd(&bar[XB_TMO], 1u); break; } }
    }
    nloc = mine > 0u ? mine : 1u; nx = cnt > 0u ? cnt : 1u;
}
__device__ __forceinline__ void xcd_barrier(const XcdBarrier& b) {
    asm volatile("s_waitcnt vmcnt(0)" ::: "memory");
    __syncthreads();
    if (threadIdx.x == 0) {
        unsigned* bar = b.bar;
        __builtin_amdgcn_s_waitcnt(0);
        unsigned nloc = b.st[0], nx = b.st[1];
        if (nloc == 0u) { xcd_barrier_complete(bar, b.x, nloc, nx); b.st[0] = nloc; b.st[1] = nx; }
        const unsigned old = xb_add(&bar[XB_XSUB(b.x)], 1u);
        const unsigned gen = old / nloc;
        if (old + 1u == (gen + 1u) * nloc) {
            __builtin_amdgcn_fence(__ATOMIC_RELEASE, "agent");
            asm volatile("s_waitcnt vmcnt(0)" ::: "memory");
            const unsigned og = xb_add(&bar[XB_TOP], 1u);
            const unsigned tg = og / nx;
            if (og + 1u == (tg + 1u) * nx) xb_add(&bar[XB_TOPGEN], 1u);
            else XB_SPIN(xb_ld(&bar[XB_TOPGEN]) == tg, bar);
            __builtin_amdgcn_fence(__ATOMIC_ACQUIRE, "agent");
            xb_add(&bar[XB_XGEN(b.x)], 1u);
            asm volatile("s_waitcnt vmcnt(0)" ::: "memory");
        } else {
            XB_SPIN(xb_ld(&bar[XB_XGEN(b.x)]) == gen, bar);
            __builtin_amdgcn_fence(__ATOMIC_ACQUIRE, "agent");
            asm volatile("s_waitcnt vmcnt(0)" ::: "memory");
        }
    }
    __syncthreads();
}

struct Args {
    const float* in[26];
    float* out; unsigned char* ws;
    int ph_lo, ph_hi, use_bar, pad;
};
enum { I_X = 0, I_P, I_GMIX, I_WIN, I_QN, I_KN, I_CONVW, I_CONVB, I_LWA, I_LBA, I_LWI, I_LBI, I_LAM, I_WABR, I_WLBR, I_WOUT, I_GMOE, I_WR, I_BR, I_WGU, I_BGU, I_WDN, I_BDN, I_GPLE, I_WPG, I_WPP };

struct Frame {
    LAS unsigned char* lds; char* lds_g;
    int tid, lane, wave, G, c;
    const Args* a;
};

template <class Map>
__device__ __forceinline__ void p0_transpose_item(const float* W, int K, int N, bf16* WT, const float* gain, LAS float* scr, int item, int lane, const Map& map) {
    const int nblk = N / 64, kb = item / nblk, nb = item % nblk, k0 = 64 * kb, n0 = 64 * nb;
#pragma unroll 4
    for (int it = 0; it < 16; ++it) { const int kk = 4 * it + (lane >> 4), nn = 4 * (lane & 15);
        f32x4 v = *(const f32x4*)(W + (size_t)(k0 + kk) * N + n0 + nn);
        if (gain) v = v * gain[k0 + kk];
        LAS float* d = scr + kk * 65 + nn; d[0] = v[0]; d[1] = v[1]; d[2] = v[2]; d[3] = v[3]; }
    LDS_WAIT(); asm volatile("" ::: "memory");
    const int c = lane & 7;
#pragma unroll
    for (int j = 0; j < 8; ++j) { const int n = (lane >> 3) + 8 * j; const LAS float* s = scr + (8 * c) * 65 + n;
        u32x4 o; o.x = pk2(s[0 * 65], s[1 * 65]); o.y = pk2(s[2 * 65], s[3 * 65]); o.z = pk2(s[4 * 65], s[5 * 65]); o.w = pk2(s[6 * 65], s[7 * 65]);
        *(u32x4*)(WT + (size_t)map(n0 + n) * K + k0 + 8 * c) = o; }
    LDS_WAIT(); asm volatile("" ::: "memory");
}
struct MapId { __device__ __forceinline__ int operator()(int n) const { return n; } };
struct MapGU { __device__ __forceinline__ int operator()(int n) const { const int up = n >> 10, j = n & 1023; return 256 * (j >> 7) + 128 * up + (j & 127); } };

__device__ __forceinline__ void p0_prologue(Frame& F) {
    const Args& A = *F.a; unsigned char* ws = A.ws;
    LAS float* scr = (LAS float*)(F.lds + F.wave * 16640);
    const int gw = F.c * 8 + F.wave, NGW = F.G * 8;
    constexpr int I_IN = 16 * (IN_W / 64);
    constexpr int I_GU1 = 16 * 32, I_GU = NE * I_GU1;
    constexpr int I_DN1 = 16 * 16, I_DN = NE * I_DN1;
    constexpr int I_SQ = 16 * 16;
    constexpr int I_PP = 4 * 16;
    constexpr int NITEMS = I_IN + I_GU + I_DN + 4 * I_SQ + I_PP;
    for (int it = gw; it < NITEMS; it += NGW) {
        int r = it;
        if (r < I_GU) { const int e = r / I_GU1; p0_transpose_item(A.in[I_WGU] + (size_t)e * 1024 * 2048, 1024, 2048, (bf16*)(ws + WS_WGU) + (size_t)e * 2048 * 1024, A.in[I_GMOE], scr, r % I_GU1, F.lane, MapGU()); continue; } r -= I_GU;
        if (r < I_DN) { const int e = r / I_DN1; p0_transpose_item(A.in[I_WDN] + (size_t)e * 1024 * 1024, 1024, 1024, (bf16*)(ws + WS_WDN) + (size_t)e * 1024 * 1024, nullptr, scr, r % I_DN1, F.lane, MapId()); continue; } r -= I_DN;
        if (r < I_IN) { p0_transpose_item(A.in[I_WIN], 1024, IN_W, (bf16*)(ws + WS_WIN), A.in[I_GMIX], scr, r, F.lane, MapId()); continue; } r -= I_IN;
        if (r < I_SQ) { p0_transpose_item(A.in[I_WABR], 1024, 1024, (bf16*)(ws + WS_WABR), nullptr, scr, r, F.lane, MapId()); continue; } r -= I_SQ;
        if (r < I_SQ) { p0_transpose_item(A.in[I_WLBR], 1024, 1024, (bf16*)(ws + WS_WLBR), nullptr, scr, r, F.lane, MapId()); continue; } r -= I_SQ;
        if (r < I_SQ) { p0_transpose_item(A.in[I_WOUT], 1024, 1024, (bf16*)(ws + WS_WOUT), nullptr, scr, r, F.lane, MapId()); continue; } r -= I_SQ;
        if (r < I_SQ) { p0_transpose_item(A.in[I_WPG], 1024, 1024, (bf16*)(ws + WS_WPG), A.in[I_GPLE], scr, r, F.lane, MapId()); continue; } r -= I_SQ;
        p0_transpose_item(A.in[I_WPP], 256, 1024, (bf16*)(ws + WS_WPP), nullptr, scr, r, F.lane, MapId());
    }
    for (int it = gw; it < 2 * 32 * 2; it += NGW) { const int hl = it >> 6, ks = (it >> 1) & 31, nt = it & 1; const int e = 16 * nt + (F.lane & 15);
        unsigned w[4];
#pragma unroll
        for (int jj = 0; jj < 4; ++jj) { float v[2];
#pragma unroll
            for (int q = 0; q < 2; ++q) { const int k = 32 * ks + 8 * (F.lane >> 4) + 2 * jj + q; const float x = A.in[I_GMOE][k] * A.in[I_WR][k * NE + e]; const float h = bf2f((unsigned short)f2bf(x)); v[q] = hl ? (x - h) : x; }
            w[jj] = pk2(v[0], v[1]); }
        *(u32x4*)(ws + WS_RW + ((size_t)it * 64 + F.lane) * 16) = (u32x4){w[0], w[1], w[2], w[3]}; }
    for (int m = gw; m < T; m += NGW) {
        const f32x4* xr = (const f32x4*)(A.in[I_X] + (size_t)m * D_MODEL) + F.lane;
        f32x4 v[4]; float s = 0.f;
#pragma unroll
        for (int j = 0; j < 4; ++j) { v[j] = xr[64 * j]; s += (v[j].x * v[j].x + v[j].y * v[j].y) + (v[j].z * v[j].z + v[j].w * v[j].w); }
        const float rstd = 1.0f / sqrtf(wave_sum(s) * (1.f / D_MODEL) + EPS);
        unsigned long long* o8 = (unsigned long long*)((bf16*)(ws + WS_U1) + (size_t)m * D_MODEL) + F.lane;
#pragma unroll
        for (int j = 0; j < 4; ++j) o8[64 * j] = (unsigned long long)pk2(v[j].x * rstd, v[j].y * rstd) | ((unsigned long long)pk2(v[j].z * rstd, v[j].w * rstd) << 32);
        const f32x4 pv = *((const f32x4*)(A.in[I_P] + (size_t)m * PLE) + F.lane);
        *((unsigned long long*)((bf16*)(ws + WS_PB) + (size_t)m * PLE) + F.lane) = (unsigned long long)pk2(pv.x, pv.y) | ((unsigned long long)pk2(pv.z, pv.w) << 32);
    }
}

__device__ __forceinline__ void p2_qknorm_rope(Frame& F) {
    const Args& A = *F.a; unsigned char* ws = A.ws;
    LAS float* tab = (LAS float*)F.lds;
    for (int i = F.tid; i < 64 * 32; i += 512) { const int id = i >> 5, j = i & 31; const float inv = powf(10000.0f, -(float)(2 * j) / 64.0f); float s, c; sincosf((float)id * inv, &s, &c); tab[2 * i] = c; tab[2 * i + 1] = s; }
    __syncthreads();
    const int sub = F.lane >> 3, li = F.lane & 7;
    const long nitems = (long)T * 10;
    for (long it0 = ((long)F.c * 8 + F.wave) * 8; it0 < nitems; it0 += (long)F.G * 64) {
        const long it = it0 + sub; const int tok = (int)(it / 10), hh = (int)(it % 10);
        bf16* p; const float* gn;
        if (hh < 8) { p = (bf16*)(ws + WS_Q) + (size_t)tok * 1024 + hh * 128; gn = A.in[I_QN]; } else { p = (bf16*)(ws + WS_K) + (size_t)tok * 256 + (hh - 8) * 128; gn = A.in[I_KN]; }
        float v[4][4]; float ss = 0.f;
#pragma unroll
        for (int q = 0; q < 4; ++q) { const u32x2 w = *(const u32x2*)(p + 32 * q + 4 * li); v[q][0] = bflo(w.x); v[q][1] = bfhi(w.x); v[q][2] = bflo(w.y); v[q][3] = bfhi(w.y);
            ss += (v[q][0] * v[q][0] + v[q][1] * v[q][1]) + (v[q][2] * v[q][2] + v[q][3] * v[q][3]); }
        ss += __shfl_xor(ss, 1); ss += __shfl_xor(ss, 2); ss += __shfl_xor(ss, 4);
        const float rstd = 1.0f / sqrtf(ss * (1.f / 128.f) + EPS);
#pragma unroll
        for (int q = 0; q < 4; ++q) { const f32x4 g = *(const f32x4*)(gn + 32 * q + 4 * li);
#pragma unroll
            for (int e = 0; e < 4; ++e) v[q][e] = v[q][e] * rstd * g[e]; }
        const int s = tok & (SEQ - 1), rid = s >> 6, cid = s & 63;
        float o[4][4];
#pragma unroll
        for (int e = 0; e < 4; ++e) { const int j = 4 * li + e;
            const float cr = tab[2 * (rid * 32 + j)], sr = tab[2 * (rid * 32 + j) + 1], cc = tab[2 * (cid * 32 + j)], sc = tab[2 * (cid * 32 + j) + 1];
            o[0][e] = v[0][e] * cr - v[1][e] * sr; o[1][e] = v[1][e] * cr + v[0][e] * sr;
            o[2][e] = v[2][e] * cc - v[3][e] * sc; o[3][e] = v[3][e] * cc + v[2][e] * sc; }
#pragma unroll
        for (int q = 0; q < 4; ++q) { u32x2 w; w.x = pk2(o[q][0], o[q][1]); w.y = pk2(o[q][2], o[q][3]); *(u32x2*)(p + 32 * q + 4 * li) = w; }
    }
    __syncthreads();
}

__device__ __forceinline__ void p3_lru_unit(Frame& F, int unit) {
    const Args& A = *F.a; unsigned char* ws = A.ws;
    const int b = unit >> 4, nb = (unit >> 1) & 7, hb = unit & 1;
    LAS unsigned char* CA = F.lds; LAS float* CF = (LAS float*)(F.lds + 32768); LAS float* HT = (LAS float*)F.lds;     LAS float* EX = (LAS float*)(F.lds + 65536); LAS float* CW = (LAS float*)(F.lds + 67584); LAS unsigned char* WB = F.lds + 70656;
    const int tid = F.tid, lane = F.lane, w = F.wave, r32 = lane & 31, hi = lane >> 5;
    const int d = w >> 2, mt = (w >> 1) & 1, cb = w & 1;
    const int chl = 32 * cb + r32;
    const int chb = 64 * hb + chl;
    const int chg = nb * 128 + chb;
    for (int i = tid; i < 5 * 128; i += 512) { const int k = i >> 7, ch = i & 127; CW[i] = (k < 4) ? A.in[I_CONVW][k * LRU_W + nb * 128 + ch] : A.in[I_CONVB][nb * 128 + ch]; }
    for (int i = tid; i < 2 * 2 * 128 * 64; i += 512) { const int e = i & 63, k = (i >> 6) & 127, gsel = (i >> 13) & 1, dd = i >> 14;
        const float* src = (gsel ? A.in[I_LWI] : A.in[I_LWA]) + ((size_t)(dd * 8 + nb) * 128 + k) * 128 + 64 * hb + e;
        *(LAS unsigned short*)(WB + (dd * 2 + gsel) * 16384 + KSWZ(e, 2 * k)) = (unsigned short)f2bf(*src); }
    const float ba = A.in[I_LBA][d * LRU_W + chg], bi = A.in[I_LBI][d * LRU_W + chg];
    float k8; { const float lam = A.in[I_LAM][d * LRU_W + chg]; const float z = -lam; const float sp = (z > 20.f) ? z : log1pf(expf(z)); k8 = -8.0f * sp * 1.4426950408889634f; }
    float carry = 0.f;
    const bf16* XR = (const bf16*)(ws + WS_XR) + (size_t)b * SEQ * 1024 + nb * 128;
    bf16* XG = (bf16*)(ws + WS_XG) + (size_t)b * SEQ * 1024 + nb * 128 + hb * 64;
    bf16* HTMP = (bf16*)(ws + WS_U1) + (size_t)b * SEQ * 1024 + nb * 128 + hb * 64;
    __syncthreads();
    for (int j = 0; j < 32; ++j) {
#pragma unroll 1
        for (int q = 0; q < 4; ++q) { const int item = q * 512 + tid; const int dd = item >> 10, r = (item >> 4) & 63, g = item & 15; const int t = 64 * (dd ? 31 - j : j) + r;
            float c8[8];
            { const f32x4 b0 = *(const LAS f32x4*)(CW + 4 * 128 + 8 * g), b1 = *(const LAS f32x4*)(CW + 4 * 128 + 8 * g + 4); c8[0] = b0[0]; c8[1] = b0[1]; c8[2] = b0[2]; c8[3] = b0[3]; c8[4] = b1[0]; c8[5] = b1[1]; c8[6] = b1[2]; c8[7] = b1[3]; }
#pragma unroll
            for (int k = 0; k < 4; ++k) { const int tt = t - 2 + k;
                if (tt >= 0 && tt < SEQ) { const u32x4 xv = *(const u32x4*)(XR + (size_t)tt * 1024 + 8 * g);
                    const f32x4 w0 = *(const LAS f32x4*)(CW + k * 128 + 8 * g), w1 = *(const LAS f32x4*)(CW + k * 128 + 8 * g + 4);
                    c8[0] += w0[0] * bflo(xv.x); c8[1] += w0[1] * bfhi(xv.x); c8[2] += w0[2] * bflo(xv.y); c8[3] += w0[3] * bfhi(xv.y);
                    c8[4] += w1[0] * bflo(xv.z); c8[5] += w1[1] * bfhi(xv.z); c8[6] += w1[2] * bflo(xv.w); c8[7] += w1[3] * bfhi(xv.w); } }
            u32x4 pw; pw.x = pk2(c8[0], c8[1]); pw.y = pk2(c8[2], c8[3]); pw.z = pk2(c8[4], c8[5]); pw.w = pk2(c8[6], c8[7]);
            *(LAS u32x4*)(CA + dd * 16384 + KSWZ(r, 16 * g)) = pw;
            if ((g >> 3) == hb) { LAS float* cf = CF + (dd * 64 + r) * 64 + 8 * (g & 7); *(LAS f32x4*)cf = (f32x4){c8[0], c8[1], c8[2], c8[3]}; *(LAS f32x4*)(cf + 4) = (f32x4){c8[4], c8[5], c8[6], c8[7]}; } }
        __syncthreads();
        f32x16 ga = {}, gi = {};
#pragma unroll
        for (int ks = 0; ks < 8; ++ks) { const bf16x8 af = *(const LAS bf16x8*)(CA + d * 16384 + KSWZ(32 * mt + r32, (ks * 16 + hi * 8) * 2));
            const bf16x8 bfa = *(const LAS bf16x8*)(WB + (d * 2 + 0) * 16384 + KSWZ(chl, (ks * 16 + hi * 8) * 2)), bfi = *(const LAS bf16x8*)(WB + (d * 2 + 1) * 16384 + KSWZ(chl, (ks * 16 + hi * 8) * 2));
            ga = __builtin_amdgcn_mfma_f32_32x32x16_bf16(af, bfa, ga, 0, 0, 0); gi = __builtin_amdgcn_mfma_f32_32x32x16_bf16(af, bfi, gi, 0, 0, 0); }
        float av[16], bv[16];
#pragma unroll
        for (int r = 0; r < 16; ++r) { const int row = 32 * mt + attn::crow(r, hi);
            const float ra = sigmoidf_(ga[r] + ba), ii = sigmoidf_(gi[r] + bi);
            const float a = __builtin_amdgcn_exp2f(k8 * ra); const float mult = sqrtf(fmaxf(1.0f - a * a, 0.f));
            av[r] = a; bv[r] = mult * ii * CF[(d * 64 + row) * 64 + chl]; }
        float A4[4], H4[4];
#pragma unroll
        for (int q = 0; q < 4; ++q) { float hh = 0.f, aa = 1.f;
            if (d == 0) {
#pragma unroll
                for (int i = 0; i < 4; ++i) { hh = av[4 * q + i] * hh + bv[4 * q + i]; aa *= av[4 * q + i]; } }
            else {
#pragma unroll
                for (int i = 3; i >= 0; --i) { hh = av[4 * q + i] * hh + bv[4 * q + i]; aa *= av[4 * q + i]; } }
            A4[q] = aa; H4[q] = hh; }
        float Ag[8], Hg[8];
#pragma unroll
        for (int q = 0; q < 4; ++q) { auto ra = __builtin_amdgcn_permlane32_swap(__float_as_uint(A4[q]), __float_as_uint(A4[q]), false, false); auto rh = __builtin_amdgcn_permlane32_swap(__float_as_uint(H4[q]), __float_as_uint(H4[q]), false, false);
            Ag[2 * q] = __uint_as_float(ra[0]); Ag[2 * q + 1] = __uint_as_float(ra[1]); Hg[2 * q] = __uint_as_float(rh[0]); Hg[2 * q + 1] = __uint_as_float(rh[1]); }
        float Ac[4], Hc[4];
        float At = 1.f, Ht = 0.f;
        if (d == 0) {
#pragma unroll
            for (int g = 0; g < 8; ++g) { if ((g & 1) == hi) { Ac[g >> 1] = At; Hc[g >> 1] = Ht; } Ht = Ag[g] * Ht + Hg[g]; At = Ag[g] * At; } }
        else {
#pragma unroll
            for (int g = 7; g >= 0; --g) { if ((g & 1) == hi) { Ac[g >> 1] = At; Hc[g >> 1] = Ht; } Ht = Ag[g] * Ht + Hg[g]; At = Ag[g] * At; } }
        if (hi == 0) { LAS float* ex = EX + ((d * 2 + mt) * 64 + chl) * 2; ex[0] = At; ex[1] = Ht; }
        __syncthreads();
        { const LAS float* e0 = EX + ((d * 2 + 0) * 64 + chl) * 2; const LAS float* e1 = EX + ((d * 2 + 1) * 64 + chl) * 2;
          const float A0 = e0[0], H0 = e0[1], A1 = e1[0], H1 = e1[1]; float hin;
          if (d == 0) { const float h1in = A0 * carry + H0; hin = mt ? h1in : carry; carry = A1 * h1in + H1; }
          else { const float h0in = A1 * carry + H1; hin = mt ? carry : h0in; carry = A0 * h0in + H0; }
#pragma unroll
          for (int q = 0; q < 4; ++q) { float hh = Ac[q] * hin + Hc[q];
              if (d == 0) {
#pragma unroll
                  for (int i = 0; i < 4; ++i) { hh = av[4 * q + i] * hh + bv[4 * q + i]; HT[(d * 64 + 32 * mt + attn::crow(4 * q + i, hi)) * 64 + chl] = hh; } }
              else {
#pragma unroll
                  for (int i = 3; i >= 0; --i) { hh = av[4 * q + i] * hh + bv[4 * q + i]; HT[(d * 64 + 32 * mt + attn::crow(4 * q + i, hi)) * 64 + chl] = hh; } } } }
        __syncthreads();
#pragma unroll 1
        for (int q = 0; q < 2; ++q) { const int item = q * 512 + tid; const int dd = item >> 9, r = (item >> 3) & 63, g8 = item & 7; const int t = 64 * (dd ? 31 - j : j) + r;
            const LAS float* hp = HT + (dd * 64 + r) * 64 + 8 * g8; const f32x4 h0 = *(const LAS f32x4*)hp, h1 = *(const LAS f32x4*)(hp + 4);
            if (j < 16) { u32x4 o; o.x = pk2(h0[0], h0[1]); o.y = pk2(h0[2], h0[3]); o.z = pk2(h1[0], h1[1]); o.w = pk2(h1[2], h1[3]); *(u32x4*)(HTMP + (size_t)t * 1024 + 8 * g8) = o; }
            else { const u32x4 ot = *(const u32x4*)(HTMP + (size_t)t * 1024 + 8 * g8); const u32x4 xg = *(const u32x4*)(XG + (size_t)t * 1024 + 8 * g8);
                u32x4 o; o.x = pk2((h0[0] + bflo(ot.x)) * bflo(xg.x), (h0[1] + bfhi(ot.x)) * bfhi(xg.x)); o.y = pk2((h0[2] + bflo(ot.y)) * bflo(xg.y), (h0[3] + bfhi(ot.y)) * bfhi(xg.y));
                o.z = pk2((h1[0] + bflo(ot.z)) * bflo(xg.z), (h1[1] + bfhi(ot.z)) * bfhi(xg.z)); o.w = pk2((h1[2] + bflo(ot.w)) * bflo(xg.w), (h1[3] + bfhi(ot.w)) * bfhi(xg.w));
                *(u32x4*)(XG + (size_t)t * 1024 + 8 * g8) = o; } }
        VM_WAIT();
        __syncthreads();
    }
}

__device__ __forceinline__ void p6_router(Frame& F) {
    const Args& A = *F.a; unsigned char* ws = A.ws;
    LAS float* LG = (LAS float*)F.lds;
    LAS int* LC = (LAS int*)(F.lds + 32768);
    LAS int* LB = (LAS int*)(F.lds + 32768 + 256);
    const float* H1 = (const float*)(ws + WS_H1);
    const int lane = F.lane, w = F.wave, l15 = lane & 15, l4 = lane >> 4;
    for (int grp = F.c; grp < T / 128; grp += F.G) {
        if (F.tid < 32) LC[F.tid] = 0;
        __syncthreads();
        const int tb = grp * 128 + w * 16;
        const float* hrow = H1 + (size_t)(tb + l15) * 1024 + 8 * l4;
        f32x4 acc0 = {0.f, 0.f, 0.f, 0.f}, acc1 = {0.f, 0.f, 0.f, 0.f}; float ss = 0.f;
#pragma unroll 4
        for (int ks = 0; ks < 32; ++ks) { const f32x4 x0 = *(const f32x4*)(hrow + 32 * ks), x1 = *(const f32x4*)(hrow + 32 * ks + 4);
            ss += (x0[0] * x0[0] + x0[1] * x0[1]) + (x0[2] * x0[2] + x0[3] * x0[3]) + (x1[0] * x1[0] + x1[1] * x1[1]) + (x1[2] * x1[2] + x1[3] * x1[3]);
            float xs[8] = {x0[0], x0[1], x0[2], x0[3], x1[0], x1[1], x1[2], x1[3]}; unsigned ph[4], pl[4];
#pragma unroll
            for (int q = 0; q < 4; ++q) { const unsigned h0 = f2bf(xs[2 * q]), h1 = f2bf(xs[2 * q + 1]); ph[q] = h0 | (h1 << 16); pl[q] = pk2(xs[2 * q] - bf2f((unsigned short)h0), xs[2 * q + 1] - bf2f((unsigned short)h1)); }
            u32x4 uh = {ph[0], ph[1], ph[2], ph[3]}, ul = {pl[0], pl[1], pl[2], pl[3]}; const bf16x8 ah = *reinterpret_cast<bf16x8*>(&uh), al = *reinterpret_cast<bf16x8*>(&ul);
            const unsigned char* rw = ws + WS_RW + ((size_t)(ks * 2) * 64 + lane) * 16;
            const bf16x8 bh0 = *(const bf16x8*)(rw), bh1 = *(const bf16x8*)(rw + 1024), bl0 = *(const bf16x8*)(rw + 65536), bl1 = *(const bf16x8*)(rw + 65536 + 1024);
            acc0 = __builtin_amdgcn_mfma_f32_16x16x32_bf16(ah, bh0, acc0, 0, 0, 0); acc0 = __builtin_amdgcn_mfma_f32_16x16x32_bf16(al, bh0, acc0, 0, 0, 0); acc0 = __builtin_amdgcn_mfma_f32_16x16x32_bf16(ah, bl0, acc0, 0, 0, 0);
            acc1 = __builtin_amdgcn_mfma_f32_16x16x32_bf16(ah, bh1, acc1, 0, 0, 0); acc1 = __builtin_amdgcn_mfma_f32_16x16x32_bf16(al, bh1, acc1, 0, 0, 0); acc1 = __builtin_amdgcn_mfma_f32_16x16x32_bf16(ah, bl1, acc1, 0, 0, 0); }
        ss += __shfl_xor(ss, 16); ss += __shfl_xor(ss, 32);
        const float rstd = 1.0f / sqrtf(ss * (1.f / 1024.f) + EPS);
        if (l4 == 0) ((float*)(ws + WS_RSTD1))[tb + l15] = rstd;
        LAS float* lg = LG + w * (16 * 33);
#pragma unroll
        for (int r = 0; r < 4; ++r) { lg[(4 * l4 + r) * 33 + l15] = acc0[r]; lg[(4 * l4 + r) * 33 + 16 + l15] = acc1[r]; }
        if (l4 == 0) lg[l15 * 33 + 32] = rstd;
        LDS_WAIT(); asm volatile("" ::: "memory");
        int ek[4] = {0, 0, 0, 0}, lp[4] = {0, 0, 0, 0}; float gk[4] = {0.f, 0.f, 0.f, 0.f};
        if (lane < 16) { float v[32]; const float rsd = lg[lane * 33 + 32];
#pragma unroll
            for (int e = 0; e < 32; ++e) v[e] = lg[lane * 33 + e] * rsd + A.in[I_BR][e];
            float tv[4];
#pragma unroll
            for (int k = 0; k < 4; ++k) { float best = -3.0e38f; int bi_ = 0;
#pragma unroll
                for (int e = 0; e < 32; ++e) { const bool gt = v[e] > best; best = gt ? v[e] : best; bi_ = gt ? e : bi_; }
                tv[k] = best; ek[k] = bi_;
#pragma unroll
                for (int e = 0; e < 32; ++e) v[e] = (e == bi_) ? -3.0e38f : v[e]; }
            float es[4], sum = 0.f;
#pragma unroll
            for (int k = 0; k < 4; ++k) { es[k] = __expf(tv[k] - tv[0]); sum += es[k]; }
            const float inv = 1.0f / sum;
#pragma unroll
            for (int k = 0; k < 4; ++k) { gk[k] = es[k] * inv; lp[k] = __hip_atomic_fetch_add(&LC[ek[k]], 1, __ATOMIC_RELAXED, __HIP_MEMORY_SCOPE_WORKGROUP); } }
        __syncthreads();
        if (F.tid < 32) LB[F.tid] = (int)__hip_atomic_fetch_add((unsigned*)(ws + WS_CTL) + CW_CNT + F.tid, (unsigned)LC[F.tid], RLX_AGENT);
        __syncthreads();
        if (lane < 16) { const int tok = tb + lane;
#pragma unroll
            for (int k = 0; k < 4; ++k) { const int pos = LB[ek[k]] + lp[k]; ((int*)(ws + WS_LIST))[(size_t)ek[k] * LIST_CAP + pos] = tok * 4 + k; ((float*)(ws + WS_GATES))[tok * 4 + k] = gk[k]; } }
        __syncthreads();
    }
}

__device__ __forceinline__ int moe_tables(Frame& F, LAS int* TAB) {
    unsigned* cnt = (unsigned*)(F.a->ws + WS_CTL) + CW_CNT;
    __syncthreads();
    if (F.tid == 0) { int acc = 0;
        for (int e = 0; e < NE; ++e) { const int c = (int)__hip_atomic_load(cnt + e, RLX_AGENT); const int nt = (c + 255) >> 8; TAB[1 + e] = acc; TAB[33 + e] = c; for (int i = 0; i < nt; ++i) TAB[96 + acc + i] = e; acc += nt; }
        TAB[0] = acc; }
    __syncthreads();
    return TAB[0];
}

__device__ __forceinline__ void p7_gather(Frame& F) {
    const Args& A = *F.a; unsigned char* ws = A.ws;
    LAS int* TAB = (LAS int*)(F.lds + LDS_TAB_OFF);
    const int ntile = moe_tables(F, TAB);
    const bf16* H1B = (const bf16*)(ws + WS_H1B); bf16* XGA = (bf16*)(ws + WS_XGATH);
    const int* list = (const int*)(ws + WS_LIST); const float* gates = (const float*)(ws + WS_GATES); const float* rstd1 = (const float*)(ws + WS_RSTD1);
    int* stok = (int*)(ws + WS_STOK); float* sscale = (float*)(ws + WS_SSCALE); float* sgate = (float*)(ws + WS_SGATE);
    const int nslots = ntile * 256;
    for (int s = F.c * 8 + F.wave; s < nslots; s += F.G * 8) {
        const int e = TAB[96 + (s >> 8)], idx = s - 256 * TAB[1 + e]; const bool valid = idx < TAB[33 + e];
        u32x4 v0 = {0u, 0u, 0u, 0u}, v1 = {0u, 0u, 0u, 0u}; int entry = -1;
        if (valid) { entry = list[(size_t)e * LIST_CAP + idx]; const bf16* src = H1B + (size_t)(entry >> 2) * 1024; v0 = *((const u32x4*)src + F.lane); v1 = *((const u32x4*)src + 64 + F.lane); }
        bf16* dst = XGA + (size_t)s * 1024; *((u32x4*)dst + F.lane) = v0; *((u32x4*)dst + 64 + F.lane) = v1;
        if (F.lane == 0) { stok[s] = entry; sscale[s] = valid ? rstd1[entry >> 2] : 0.f; sgate[s] = valid ? gates[entry] : 0.f; }
    }
}

__device__ __forceinline__ void p10_combine(Frame& F) {
    const Args& A = *F.a; unsigned char* ws = A.ws;
    const float* H1 = (const float*)(ws + WS_H1); const bf16* Y = (const bf16*)(ws + WS_XGATH); bf16* H2B = (bf16*)(ws + WS_H1B); float* rstd2 = (float*)(ws + WS_RSTD2);
    for (int m = F.c * 8 + F.wave; m < T; m += F.G * 8) {
        float ss = 0.f;
#pragma unroll
        for (int j = 0; j < 4; ++j) { const int col = 256 * j + 4 * F.lane; f32x4 h = *(const f32x4*)(H1 + (size_t)m * 1024 + col);
#pragma unroll
            for (int k = 0; k < 4; ++k) { const u32x2 y = *(const u32x2*)(Y + ((size_t)m * 4 + k) * 1024 + col); h[0] += bflo(y.x); h[1] += bfhi(y.x); h[2] += bflo(y.y); h[3] += bfhi(y.y); }
            ss += (h[0] * h[0] + h[1] * h[1]) + (h[2] * h[2] + h[3] * h[3]);
            *(f32x4*)(A.out + (size_t)m * 1024 + col) = h; u32x2 wv; wv.x = pk2(h[0], h[1]); wv.y = pk2(h[2], h[3]); *(u32x2*)(H2B + (size_t)m * 1024 + col) = wv; }
        ss = wave_sum(ss);
        if (F.lane == 0) rstd2[m] = 1.0f / sqrtf(ss * (1.f / 1024.f) + EPS);
    }
}

constexpr int NPHASE = 12;
__global__ void __launch_bounds__(512, 2) mk_fwd(Args args) {
    extern __shared__ __attribute__((aligned(16))) unsigned char lds[];
    Frame F; F.lds = (LAS unsigned char*)lds; F.lds_g = (char*)lds; F.tid = threadIdx.x; F.lane = F.tid & 63; F.wave = __builtin_amdgcn_readfirstlane(F.tid >> 6); F.G = gridDim.x; F.c = blockIdx.x; F.a = &args;
    unsigned char* ws = args.ws;
    volatile LAS unsigned* LCTL = (volatile LAS unsigned*)(F.lds + LDS_CTL_OFF);
    if (F.tid < 64) LCTL[F.tid] = 0u;
    __syncthreads();
    XcdBarrier bar; bar.bar = (unsigned*)(ws + WS_CTL) + CW_BAR; bar.x = 0; bar.st = nullptr;
    if (args.use_bar) bar = xcd_barrier_post((unsigned*)(ws + WS_CTL) + CW_BAR, LCTL);
    const int lo = args.ph_lo, hi = args.ph_hi;
#ifdef PHASE_MASK
#define IN(k) (((PHASE_MASK >> (k)) & 1) && lo <= (k) && (k) < hi)
#else
#define IN(k) (lo <= (k) && (k) < hi)
#endif
#define SEAM(k) do { if (IN(k) && IN((k) + 1)) xcd_barrier(bar); } while (0)
    LAS int* TAB = (LAS int*)(F.lds + LDS_TAB_OFF);

    if (IN(0)) { p0_prologue(F); } SEAM(0);

    if (IN(1)) {
        { pg8::Gemm g{(const bf16*)(ws + WS_U1), (const bf16*)(ws + WS_WIN), T, IN_W, 1024}; pg8::StaticOrder S; S.init(g, F.G, F.c);
          pg8::EpiInProj E{(bf16*)(ws + WS_Q), (bf16*)(ws + WS_K), (bf16*)(ws + WS_V), (bf16*)(ws + WS_XR), (bf16*)(ws + WS_XG), (bf16*)(ws + WS_GA), (bf16*)(ws + WS_GR)};
          pg8::gemm_phase<pg8::EpiInProj, pg8::StaticOrder>(F.lds, g, S, E); }
        { pg8::Gemm g{(const bf16*)(ws + WS_PB), (const bf16*)(ws + WS_WPP), T, 1024, PLE}; pg8::StaticOrder S; S.init(g, F.G, F.c);
          pg8::EpiBf16 E{(bf16*)(ws + WS_PP), 1024};
          pg8::gemm_phase<pg8::EpiBf16, pg8::StaticOrder>(F.lds, g, S, E); }
    } SEAM(1);

    if (IN(2)) { p2_qknorm_rope(F); } SEAM(2);

    if (IN(3)) {
        for (int L = F.c; L < BATCH * NQH * (SEQ / 256); L += F.G) {
            const int grp = (L >> 8) * 8 + (L & 7), jj = (L & 255) >> 3;
            const int b = grp >> 1, kvh = grp & 1, h = kvh * 4 + (jj & 3), qb = jj >> 2;
            bf16* Qb = (bf16*)(ws + WS_Q) + ((size_t)b * SEQ + qb * 256) * 1024 + h * 128;
            const bf16* Kh = (const bf16*)(ws + WS_K) + (size_t)b * SEQ * 256 + kvh * 128; const bf16* Vh = (const bf16*)(ws + WS_V) + (size_t)b * SEQ * 256 + kvh * 128;
            attn::attn_dense_body(Qb, Kh, Vh, Qb, SEQ, F.lds_g);
        }
        for (int u = F.c; u < 256; u += F.G) p3_lru_unit(F, u);
    } SEAM(3);

    if (IN(4)) {
        { pg8::Gemm g{(const bf16*)(ws + WS_Q), (const bf16*)(ws + WS_WABR), T, 1024, 1024}; pg8::StaticOrder S; S.init(g, F.G, F.c);
          pg8::EpiGate<0> E{(const bf16*)(ws + WS_GA), nullptr, (bf16*)(ws + WS_U1)};
          pg8::gemm_phase<pg8::EpiGate<0>, pg8::StaticOrder>(F.lds, g, S, E); }
        VM_WAIT(); __syncthreads();
        { pg8::Gemm g{(const bf16*)(ws + WS_XG), (const bf16*)(ws + WS_WLBR), T, 1024, 1024}; pg8::StaticOrder S; S.init(g, F.G, F.c);
          pg8::EpiGate<1> E{(const bf16*)(ws + WS_GR), (const bf16*)(ws + WS_U1), (bf16*)(ws + WS_MRG)};
          pg8::gemm_phase<pg8::EpiGate<1>, pg8::StaticOrder>(F.lds, g, S, E); }
    } SEAM(4);

    if (IN(5)) {
        pg8::Gemm g{(const bf16*)(ws + WS_MRG), (const bf16*)(ws + WS_WOUT), T, 1024, 1024}; pg8::StaticOrder S; S.init(g, F.G, F.c);
        pg8::EpiResid E{args.in[I_X], (float*)(ws + WS_H1), (bf16*)(ws + WS_H1B)};
        pg8::gemm_phase<pg8::EpiResid, pg8::StaticOrder>(F.lds, g, S, E);
    } SEAM(5);

    if (IN(6)) { p6_router(F); } SEAM(6);

    if (IN(7)) { p7_gather(F); } SEAM(7);

    if (IN(8)) {
        const int ntile = moe_tables(F, TAB);
        pg8::Gemm g{(const bf16*)(ws + WS_XGATH), (const bf16*)(ws + WS_WGU), CAP, 2048, 1024}; pg8::MoeOrder S; S.init_moe(g, ntile, F.G, F.c, TAB + 96, (size_t)2048 * 1024 * 2);
        pg8::EpiSwiglu E{TAB + 96, args.in[I_BGU], (const float*)(ws + WS_SSCALE), (bf16*)(ws + WS_ACT)};
        pg8::gemm_phase<pg8::EpiSwiglu, pg8::MoeOrder>(F.lds, g, S, E);
    } SEAM(8);

    if (IN(9)) {
        const int ntile = moe_tables(F, TAB);
        pg8::Gemm g{(const bf16*)(ws + WS_ACT), (const bf16*)(ws + WS_WDN), CAP, 1024, 1024}; pg8::MoeOrder S; S.init_moe(g, ntile, F.G, F.c, TAB + 96, (size_t)1024 * 1024 * 2);
        pg8::EpiDown E{TAB + 96, args.in[I_BDN], (const float*)(ws + WS_SGATE), (const int*)(ws + WS_STOK), (bf16*)(ws + WS_XGATH)};
        pg8::gemm_phase<pg8::EpiDown, pg8::MoeOrder>(F.lds, g, S, E);
    } SEAM(9);

    if (IN(10)) { p10_combine(F); } SEAM(10);

    if (IN(11)) {
        pg8::Gemm g{(const bf16*)(ws + WS_H1B), (const bf16*)(ws + WS_WPG), T, 1024, 1024}; pg8::StaticOrder S; S.init(g, F.G, F.c);
        pg8::EpiPle E{args.out, (const float*)(ws + WS_RSTD2), (const bf16*)(ws + WS_PP)};
        pg8::gemm_phase<pg8::EpiPle, pg8::StaticOrder>(F.lds, g, S, E);
    }
#undef IN
#undef SEAM
}

extern "C" void kernel_launch(void* const* d_in, const int* in_sizes, int n_in, void* d_out, int out_size, void* d_ws, size_t ws_size, hipStream_t stream) {
    static int grid = 0;
    if (grid == 0) {
        if (n_in != 26 || out_size != T * D_MODEL || ws_size < WS_END) { fprintf(stderr, "kernel_launch: unexpected shapes (n_in %d out %d ws %zu, need ws >= %zu)\n", n_in, out_size, ws_size, (size_t)WS_END); grid = -1; return; }
        int dev = 0, cus = 0, per_cu = 0;
        if (hipGetDevice(&dev) != hipSuccess || hipDeviceGetAttribute(&cus, hipDeviceAttributeMultiprocessorCount, dev) != hipSuccess) { grid = -1; return; }
        if (hipFuncSetAttribute((const void*)mk_fwd, hipFuncAttributeMaxDynamicSharedMemorySize, LDS_BYTES) != hipSuccess) { fprintf(stderr, "kernel_launch: hipFuncSetAttribute failed\n"); grid = -1; return; }
        if (hipOccupancyMaxActiveBlocksPerMultiprocessor(&per_cu, (const void*)mk_fwd, 512, LDS_BYTES) != hipSuccess || per_cu < 1) { fprintf(stderr, "kernel_launch: occupancy query reports %d\n", per_cu); per_cu = 1; }
        (void)hipGetLastError();
        grid = cus;
    }
    if (grid < 0) return;
    (void)hipMemsetAsync((char*)d_ws + WS_CTL, 0, CTL_ZERO_BYTES, stream);
    Args a{};
    for (int i = 0; i < 26; ++i) a.in[i] = (const float*)d_in[i];
    a.out = (float*)d_out; a.ws = (unsigned char*)d_ws; a.pad = 0;
#if MK_N_LAUNCHES == 1
    a.ph_lo = 0; a.ph_hi = NPHASE; a.use_bar = 1;
    hipLaunchKernelGGL(mk_fwd, dim3(grid), dim3(512), LDS_BYTES, stream, a);
#else
    for (int p = 0; p < NPHASE; ++p) { a.ph_lo = p; a.ph_hi = p + 1; a.use_bar = 0; hipLaunchKernelGGL(mk_fwd, dim3(grid), dim3(512), LDS_BYTES, stream, a); }
#endif
}
```

```cpp
#ifdef NOMOE
#define NOMOE_K 0
#define PHASE_MASK 0x67F
#else
#define NOMOE_K 4
#endif
#include <hip/hip_runtime.h>
#include <cstdio>
#include <cstdint>
#include <cmath>

#ifndef MK_N_LAUNCHES
#define MK_N_LAUNCHES 1
#endif

#define GAS __attribute__((address_space(1)))
#define LAS __attribute__((address_space(3)))
typedef unsigned short bf16;
typedef unsigned short bf16_t;
typedef short bf16x8 __attribute__((ext_vector_type(8)));
typedef short s16x4 __attribute__((ext_vector_type(4)));
typedef float f32x4 __attribute__((ext_vector_type(4)));
typedef float f32x2 __attribute__((ext_vector_type(2)));
typedef float f32x16 __attribute__((ext_vector_type(16)));
typedef unsigned u32x4 __attribute__((ext_vector_type(4)));
typedef unsigned u32x2 __attribute__((ext_vector_type(2)));
typedef GAS unsigned gu32;

constexpr int D_MODEL = 1024, BATCH = 16, SEQ = 2048, T = BATCH * SEQ;
constexpr int NQH = 8, NKVH = 2, HD = 128, QW = NQH * HD, KVW = NKVH * HD;
constexpr int LRU_W = 1024, LRU_NB = 8, LRU_BD = 128;
constexpr int NE = 32, TOPK = 4, DEXP = 1024, PLE = 256;
constexpr int IN_W = QW + 2 * KVW + 2 * LRU_W + 2 * D_MODEL;
constexpr float EPS = 1e-6f;
constexpr int TK = T * TOPK;
constexpr int CAP = TK + NE * 256;
constexpr int LIST_CAP = T;

constexpr size_t MiB = 1u << 20;
constexpr size_t WS_CTL = 0, CTL_ZERO_BYTES = 64 * 1024;
constexpr size_t WS_RSTD1 = 512 * 1024;
constexpr size_t WS_RSTD2 = WS_RSTD1 + 128 * 1024;
constexpr size_t WS_RW = WS_RSTD2 + 128 * 1024;
constexpr size_t WS_LIST = 1 * MiB;
constexpr size_t WS_GATES = 5 * MiB;
constexpr size_t WS_STOK = WS_GATES + 512 * 1024;
constexpr size_t WS_SSCALE = WS_STOK + 640 * 1024;
constexpr size_t WS_SGATE = WS_SSCALE + 640 * 1024;
constexpr size_t WS_WIN = 8 * MiB;
constexpr size_t WS_WGU = 19 * MiB;
constexpr size_t WS_WDN = 147 * MiB;
constexpr size_t WS_H1F8 = 83 * MiB;
constexpr size_t WS_WABR = 211 * MiB, WS_WLBR = 213 * MiB, WS_WOUT = 215 * MiB, WS_WPG = 217 * MiB, WS_WPP = 219 * MiB;
constexpr size_t WS_PP = 221 * MiB;
constexpr size_t WS_O8 = WS_PP + 32 * MiB;
constexpr size_t WS_H1 = 285 * MiB;
constexpr size_t WS_H1B = 413 * MiB;
constexpr size_t WS_H2H = 869 * MiB;
constexpr size_t WS_S = 477 * MiB;
constexpr size_t WS_Q = WS_S;
constexpr size_t WS_K = WS_Q + 64 * MiB;
constexpr size_t WS_V = WS_K + 16 * MiB;
constexpr size_t WS_XR = WS_V + 16 * MiB;
constexpr size_t WS_XG = WS_XR + 64 * MiB;
constexpr size_t WS_GA = WS_XG + 64 * MiB;
constexpr size_t WS_GR = WS_GA + 64 * MiB;
constexpr size_t WS_U1 = WS_GR + 64 * MiB;
constexpr size_t WS_PB = WS_U1 + 64 * MiB;
constexpr size_t WS_MRG = WS_PB + 16 * MiB;
constexpr size_t WS_S_END1 = WS_MRG + 64 * MiB;
constexpr size_t WS_YK = WS_S;
constexpr size_t WS_ACT = WS_S + 256 * MiB;
constexpr size_t WS_END = 973 * MiB;
static_assert(WS_S_END1 <= 1024 * MiB && WS_END <= 1024 * MiB, "workspace map must fit 1 GiB");
static_assert(WS_SGATE + 640 * 1024 <= WS_WIN && (size_t)CAP * 4 <= 640 * 1024, "meta region");
constexpr int CW_CNT = 64;
constexpr int CW_BAR = 1024;

constexpr int LDS_BYTES = 163840;
constexpr int LDS_GMAP_OFF = 131072;
constexpr int LDS_TAB_OFF = 151552;
constexpr int LDS_CTL_OFF = 155648;

__device__ __forceinline__ unsigned f2bf(float f) { unsigned u = __builtin_bit_cast(unsigned, f); return (u + 0x7fffu + ((u >> 16) & 1u)) >> 16; }
__device__ __forceinline__ unsigned pk2(float lo, float hi) { return f2bf(lo) | (f2bf(hi) << 16); }
__device__ __forceinline__ float bf2f(unsigned short h) { return __builtin_bit_cast(float, (unsigned)h << 16); }
__device__ __forceinline__ float bflo(unsigned w) { return __builtin_bit_cast(float, w << 16); }
__device__ __forceinline__ float bfhi(unsigned w) { return __builtin_bit_cast(float, w & 0xffff0000u); }
__device__ __forceinline__ unsigned cvt_pk_bf16(float lo, float hi) { unsigned r; asm volatile("v_cvt_pk_bf16_f32 %0, %1, %2" : "=v"(r) : "v"(lo), "v"(hi)); return r; }
__device__ __forceinline__ float sigmoidf_(float x) { return __builtin_amdgcn_rcpf(1.0f + __builtin_amdgcn_exp2f(-1.4426950408889634f * x)); }
__device__ __forceinline__ float gelu_tanh_(float x) { const float u = 1.5957691216057308f * (x + 0.044715f * x * x * x); return x * sigmoidf_(u); }
__device__ __forceinline__ float wave_sum(float v) {
#pragma unroll
    for (int o = 1; o < 64; o <<= 1) v += __shfl_xor(v, o);
    return v;
}
#define LDS_WAIT() asm volatile("s_waitcnt lgkmcnt(0)" ::: "memory")
#define VM_WAIT() asm volatile("s_waitcnt vmcnt(0)" ::: "memory")
#define RLX_AGENT __ATOMIC_RELAXED, __HIP_MEMORY_SCOPE_AGENT

namespace pg8 {
#define PG8_LAS __attribute__((address_space(3)))
constexpr int BM = 256, BK = 64, HALF = 128, HTB = HALF * BK * 2, STAGE_BYTES = 8 * HTB, NXCD = 8, WGM = 8;
typedef int v4i_t __attribute__((ext_vector_type(4)));
typedef int v8i_t __attribute__((ext_vector_type(8)));
#ifdef F8_PLAIN
constexpr float F8_ACC_SCALE = 1.0f / 32.0f;
#else
constexpr float F8_ACC_SCALE = 1.0f;
#endif
constexpr int F8_SCALE_W = 0x7A7A7A7A, F8_SCALE_A = 0x7F7F7F7F;
__host__ __device__ __forceinline__ int lds_byte(int r, int c) { const int st = (r >> 4) * 2 + (c >> 5), rr = r & 15, cc = c & 31, ob = rr * 64 + cc * 2; return st * 1024 + (ob ^ (((ob >> 9) & 1) << 5)); }
__host__ __device__ __forceinline__ void stage_rc(int b, int& R, int& C) { const int st = b / 1024, sb = b % 1024, swz = sb ^ (((sb >> 9) & 1) << 5); R = (st >> 1) * 16 + swz / 64; C = (st & 1) * 32 + (swz % 64) / 2; }
__host__ __device__ __forceinline__ int perm32(int rho) { const int n = rho >> 4, i = rho & 15; return 8 * (i >> 2) + 4 * n + (i & 3); }
__host__ __device__ __forceinline__ int g8(int r) { const int t = r >> 1; return 4 * (((t + 2) >> 2) & 1) + (t & 1) + 2 * ((t >> 2) & 1); }
__host__ __device__ __forceinline__ void stage_rc8(int b, int& R, int& Cb) { const int blk = b >> 11, ri = (b >> 7) & 15, slot = (b >> 4) & 7; R = blk * 16 + ri; Cb = 16 * (slot ^ g8(ri)); }

struct Unit { int pm, pn; };
struct Gemm { const void* A; const void* Bt; int M, N, K, kb; };

struct StaticOrder {
    static constexpr bool GATHER = false;
    int nM, nN, nwg, G, c; const char* A; const char* B; size_t tstep;
    __device__ void init(const Gemm& g, int G_, int c_) { nM = g.M / BM; nN = g.N / BM; nwg = nM * nN; G = G_; c = c_; A = (const char*)g.A; B = (const char*)g.Bt; tstep = (size_t)BM * g.kb; }
    __device__ bool next(int i, Unit& u) const {
        const long L = (long)i * G + c; if (L >= nwg) return false;
        int wgid = (int)L; { const int q = nwg / NXCD, r = nwg % NXCD, xcd = wgid % NXCD, off = wgid / NXCD; wgid = (xcd < r ? xcd * (q + 1) : r * (q + 1) + (xcd - r) * q) + off; }
        const int nig = WGM * nN, gid = wgid / nig, fm = gid * WGM, gsz = (nM - fm) < WGM ? (nM - fm) : WGM;
        u.pm = fm + ((wgid % nig) % gsz); u.pn = (wgid % nig) / gsz; return true;
    }
    __device__ __forceinline__ const char* a_ptr(const Unit& u) const { return A + (size_t)u.pm * tstep; }
    __device__ __forceinline__ const char* b_ptr(const Unit& u) const { return B + (size_t)u.pn * tstep; }
};
struct MoeOrder : StaticOrder {
    const PG8_LAS int* t2e; size_t estride;
    __device__ void init_moe(const Gemm& g, int nMdyn, int G_, int c_, const PG8_LAS int* t2e_, size_t estride_) { init(g, G_, c_); nM = nMdyn; nwg = nM * nN; t2e = t2e_; estride = estride_; }
    __device__ __forceinline__ const char* b_ptr(const Unit& u) const { return B + (size_t)__builtin_amdgcn_readfirstlane(t2e[u.pm]) * estride + (size_t)u.pn * tstep; }
};
struct MoeGatherOrder : MoeOrder {
    static constexpr bool GATHER = true;
    const PG8_LAS int* gmap;
    __device__ __forceinline__ const char* a_ptr(const Unit&) const { return A; }
};

template <class Epi, class Sched, bool ALIGN_EPI = true, bool F8 = false>
__device__ __forceinline__ void gemm_phase(PG8_LAS unsigned char* lds, const Gemm g, const Sched& S, const Epi& E) {
    const int tid = threadIdx.x, wid = __builtin_amdgcn_readfirstlane(tid >> 6), lane = tid & 63, wr = wid >> 2, wc = wid & 3, fr = lane & 15, fq = lane >> 4;
    const int KB = g.kb, nt = KB / 128;
    unsigned voffA[2], voffB[2], voffA1[2] = {0u, 0u}, gC[2]; int gR[2];
#pragma unroll
    for (int i = 0; i < 2; ++i) { int R, Cb; if (F8) stage_rc8(tid * 16 + i * 8192, R, Cb); else { int C; stage_rc(tid * 16 + i * 8192, R, C); Cb = 2 * C; }
        const int Rb = Epi::PERM ? ((R & ~31) + perm32(R & 31)) : R;
        voffA[i] = (unsigned)(R * KB + Cb); voffB[i] = (unsigned)(Rb * KB + Cb); gR[i] = R; gC[i] = (unsigned)Cb; }
    const size_t kstep = (size_t)128;
    const size_t hstep = (size_t)HALF * KB;
    const unsigned ldsw = (unsigned)wid * 1024u;
    int aoffk[2], boffk[2];
    if (F8) { const int la0 = fr * 128 + 16 * ((2 * fq) ^ g8(fr)); aoffk[0] = wr * 8192 + la0; aoffk[1] = wr * 8192 + (la0 ^ 16); boffk[0] = wc * 4096 + la0; boffk[1] = wc * 4096 + (la0 ^ 16); }
    else { const int aoff = lds_byte(wr * 64 + fr, fq * 8), boff = lds_byte(wc * 32 + fr, fq * 8); aoffk[0] = aoff; aoffk[1] = aoff + 1024; boffk[0] = boff; boffk[1] = boff + 1024; }
#define PG8_SA(b, h) (((b) * 2 + (h)) * HTB)
#define PG8_SB(b, h) ((4 + (b) * 2 + (h)) * HTB)
#define PG8_STAGE(bufoff, gbase, voff) do { _Pragma("unroll") for (int _i = 0; _i < 2; ++_i) \
        __builtin_amdgcn_global_load_lds((const unsigned*)((const char*)(gbase) + (voff)[_i]), (PG8_LAS unsigned*)(lds + (bufoff) + ldsw + _i * 8192), 16, 0, 0); } while (0)
#define PG8_GLOAD(ui_) do { if constexpr (Sched::GATHER) { _Pragma("unroll") for (int _i = 0; _i < 2; ++_i) { \
        voffA[_i] = (unsigned)S.gmap[(ui_) * 256 + gR[_i]] * (unsigned)KB + gC[_i]; voffA1[_i] = (unsigned)S.gmap[(ui_) * 256 + 128 + gR[_i]] * (unsigned)KB + gC[_i]; } } } while (0)
#define PG8_STAGE_A(bufoff, gbase, half) do { if constexpr (Sched::GATHER) { if (half) PG8_STAGE(bufoff, gbase, voffA1); else PG8_STAGE(bufoff, gbase, voffA); } \
        else PG8_STAGE(bufoff, (gbase) + (half) * hstep, voffA); } while (0)
#define PG8_LD16(off) (*(const PG8_LAS v4i_t*)(lds + (off)))
#define PG8_LDA(dst, b, h) do { _Pragma("unroll") for (int m = 0; m < 4; ++m) dst[m] = __builtin_shufflevector(PG8_LD16(PG8_SA(b, h) + aoffk[0] + m * 2048), PG8_LD16(PG8_SA(b, h) + aoffk[1] + m * 2048), 0, 1, 2, 3, 4, 5, 6, 7); } while (0)
#define PG8_LDB(dst, b, h) do { _Pragma("unroll") for (int n = 0; n < 2; ++n) dst[n] = __builtin_shufflevector(PG8_LD16(PG8_SB(b, h) + boffk[0] + n * 2048), PG8_LD16(PG8_SB(b, h) + boffk[1] + n * 2048), 0, 1, 2, 3, 4, 5, 6, 7); } while (0)
#define PG8_BFLO(x) __builtin_bit_cast(bf16x8, __builtin_shufflevector(x, x, 0, 1, 2, 3))
#define PG8_BFHI(x) __builtin_bit_cast(bf16x8, __builtin_shufflevector(x, x, 4, 5, 6, 7))
#ifdef F8_PLAIN
#define F8_MMA_ONE(c, w, a) do { _Pragma("unroll") for (int q_ = 0; q_ < 4; ++q_) { const long wq_ = ((long)(unsigned)(w)[2 * q_ + 1] << 32) | (unsigned)(w)[2 * q_], aq_ = ((long)(unsigned)(a)[2 * q_ + 1] << 32) | (unsigned)(a)[2 * q_]; \
        c = __builtin_amdgcn_mfma_f32_16x16x32_fp8_fp8(wq_, aq_, c, 0, 0, 0); } } while (0)
#else
#define F8_MMA_ONE(c, w, a) asm volatile("v_mfma_scale_f32_16x16x128_f8f6f4 %0, %1, %2, %0, %3, %4 op_sel_hi:[0,0,0]" : "+v"(c) : "v"(w), "v"(a), "v"(f8sw), "v"(f8sa))
#endif
#define PG8_MMA(ai, bj, At, Bt) do { __builtin_amdgcn_s_setprio(1); _Pragma("unroll") for (int m = 0; m < 4; ++m) _Pragma("unroll") for (int n = 0; n < 2; ++n) { \
        if constexpr (F8) { F8_MMA_ONE(acc[ai][bj][m][n], Bt[n], At[m]); } \
        else { acc[ai][bj][m][n] = __builtin_amdgcn_mfma_f32_16x16x32_bf16(PG8_BFLO(Bt[n]), PG8_BFLO(At[m]), acc[ai][bj][m][n], 0, 0, 0); \
               acc[ai][bj][m][n] = __builtin_amdgcn_mfma_f32_16x16x32_bf16(PG8_BFHI(Bt[n]), PG8_BFHI(At[m]), acc[ai][bj][m][n], 0, 0, 0); } } __builtin_amdgcn_s_setprio(0); } while (0)
#define PG8_WAIT_V(n) asm volatile("s_waitcnt vmcnt(" #n ")" ::: "memory")
#define PG8_WAIT_L(n) asm volatile("s_waitcnt lgkmcnt(" #n ")" ::: "memory")
#define PG8_BAR __builtin_amdgcn_s_barrier()
#define PG8_SCHED __builtin_amdgcn_sched_barrier(0)
    Unit cur, nxt; int ui = 0;
    if (!S.next(0, cur)) return;
    f32x4 acc[2][2][4][2];
#pragma unroll
    for (int a = 0; a < 2; ++a)
#pragma unroll
        for (int b = 0; b < 2; ++b)
#pragma unroll
            for (int m = 0; m < 4; ++m)
#pragma unroll
                for (int n = 0; n < 2; ++n) acc[a][b][m][n] = (f32x4){0.f, 0.f, 0.f, 0.f};
    const int f8sw = F8_SCALE_W, f8sa = F8_SCALE_A; (void)f8sw; (void)f8sa;
    v8i_t At[4], B0[2], B1[2];
    const char* cA = S.a_ptr(cur); const char* cB = S.b_ptr(cur);
    PG8_GLOAD(0);
    PG8_STAGE(PG8_SB(0, 0), cB, voffB); PG8_STAGE(PG8_SB(0, 1), cB + hstep, voffB); PG8_STAGE_A(PG8_SA(0, 0), cA, 0); PG8_STAGE_A(PG8_SA(0, 1), cA, 1);
    if (wr == 1) PG8_BAR;
    PG8_WAIT_V(2); PG8_BAR;
    PG8_STAGE(PG8_SB(1, 0), cB + kstep, voffB); PG8_STAGE_A(PG8_SA(1, 0), cA + kstep, 0); PG8_STAGE(PG8_SB(1, 1), cB + hstep + kstep, voffB);
    PG8_WAIT_V(6); PG8_BAR;
    for (;;) {
        const bool has_next = S.next(ui + 1, nxt);
        const char* nA = has_next ? S.a_ptr(nxt) : cA; const char* nB = has_next ? S.b_ptr(nxt) : cB;
#pragma unroll 1
        for (int t = 0; t < nt; t += 2) {
            const bool last = (t == nt - 2);
            const char* a1 = cA + (size_t)(t + 1) * kstep;
            const char* a2 = last ? nA : cA + (size_t)(t + 2) * kstep; const char* b2 = last ? nB : cB + (size_t)(t + 2) * kstep;
            const char* a3 = a2 + kstep; const char* b3 = b2 + kstep;
            PG8_LDB(B0, 0, 0); PG8_LDB(B1, 0, 1); PG8_SCHED; PG8_LDA(At, 0, 0); PG8_STAGE_A(PG8_SA(1, 1), a1, 1);
            if (last && has_next) PG8_GLOAD(ui + 1);
            PG8_WAIT_V(8); PG8_WAIT_L(0); PG8_BAR; PG8_MMA(0, 0, At, B0); PG8_MMA(0, 1, At, B1); PG8_BAR; PG8_SCHED;
            PG8_LDA(At, 0, 1); PG8_STAGE(PG8_SB(0, 0), b2, voffB); PG8_STAGE(PG8_SB(0, 1), b2 + hstep, voffB); PG8_STAGE_A(PG8_SA(0, 0), a2, 0);
            PG8_WAIT_V(8); PG8_WAIT_L(0); PG8_BAR; PG8_MMA(1, 0, At, B0); PG8_MMA(1, 1, At, B1); PG8_BAR; PG8_SCHED;
            PG8_LDB(B0, 1, 0); PG8_LDB(B1, 1, 1); PG8_SCHED; PG8_LDA(At, 1, 0); PG8_STAGE_A(PG8_SA(0, 1), a2, 1);
            PG8_WAIT_V(8); PG8_WAIT_L(0); PG8_BAR; PG8_MMA(0, 0, At, B0); PG8_MMA(0, 1, At, B1); PG8_BAR; PG8_SCHED;
            PG8_LDA(At, 1, 1); PG8_STAGE(PG8_SB(1, 0), b3, voffB); PG8_STAGE(PG8_SB(1, 1), b3 + hstep, voffB); PG8_STAGE_A(PG8_SA(1, 0), a3, 0);
            PG8_WAIT_V(8); PG8_WAIT_L(0); PG8_BAR; PG8_MMA(1, 0, At, B0); PG8_MMA(1, 1, At, B1); PG8_BAR; PG8_SCHED;
        }
        if constexpr (ALIGN_EPI) { if (wr == 0) PG8_BAR; }
        if constexpr (F8) asm volatile("s_nop 7\n\ts_nop 7" ::: "memory");
        E(acc, cur, wr, wc, fr, fq);
        if (!has_next) break;
#pragma unroll
        for (int a = 0; a < 2; ++a)
#pragma unroll
            for (int b = 0; b < 2; ++b)
#pragma unroll
                for (int m = 0; m < 4; ++m)
#pragma unroll
                    for (int n = 0; n < 2; ++n) acc[a][b][m][n] = (f32x4){0.f, 0.f, 0.f, 0.f};
        cur = nxt; cA = nA; cB = nB; ++ui;
        if constexpr (ALIGN_EPI) { if (wr == 1) PG8_BAR; }
    }
    PG8_WAIT_V(0);
    if constexpr (!ALIGN_EPI) { if (wr == 0) PG8_BAR; }
    PG8_BAR;
#undef PG8_SA
#undef PG8_SB
#undef PG8_STAGE
#undef PG8_LDA
#undef PG8_LDB
#undef PG8_MMA
#undef PG8_LD16
#undef PG8_GLOAD
#undef PG8_STAGE_A
#undef PG8_BFLO
#undef PG8_BFHI
#undef PG8_WAIT_V
#undef PG8_WAIT_L
#undef PG8_BAR
#undef PG8_SCHED
}

typedef f32x4 Acc[2][2][4][2];
struct EpiInProj {
    static constexpr bool PERM = true;
    bf16_t *Q, *Kb, *Vb, *XR, *XG, *GA, *GR; int pn0;
    __device__ __forceinline__ void operator()(const Acc& acc, const Unit& u, int wr, int wc, int fr, int fq) const {
        const int pn = pn0 == 0 ? (u.pn < 6 ? u.pn : u.pn + 8) : u.pn + 6; bf16_t* base; int ldc, colt, act;
        if (pn < 4) { base = Q; ldc = 1024; colt = pn * 256; act = 0; }
        else if (pn == 4) { base = Kb; ldc = 256; colt = 0; act = 0; }
        else if (pn == 5) { base = Vb; ldc = 256; colt = 0; act = 0; }
        else if (pn < 10) { base = XR; ldc = 1024; colt = (pn - 6) * 256; act = 0; }
        else if (pn < 14) { base = XG; ldc = 1024; colt = (pn - 10) * 256; act = 1; }
        else if (pn < 18) { base = GA; ldc = 1024; colt = (pn - 14) * 256; act = 2; }
        else { base = GR; ldc = 1024; colt = (pn - 18) * 256; act = 2; }
        const int row0 = u.pm * BM + wr * 64 + fr, col0 = colt + wc * 32 + 8 * fq;
#pragma unroll
        for (int ai = 0; ai < 2; ++ai)
#pragma unroll
            for (int m = 0; m < 4; ++m) { bf16_t* rowp = base + (size_t)(row0 + ai * HALF + m * 16) * ldc + col0;
#pragma unroll
                for (int bj = 0; bj < 2; ++bj) { f32x4 v0 = acc[ai][bj][m][0], v1 = acc[ai][bj][m][1];
                    if (act == 1) {
#pragma unroll
                        for (int e = 0; e < 4; ++e) { v0[e] = gelu_tanh_(v0[e]); v1[e] = gelu_tanh_(v1[e]); } }
                    else if (act == 2) {
#pragma unroll
                        for (int e = 0; e < 4; ++e) { v0[e] = sigmoidf_(v0[e]); v1[e] = sigmoidf_(v1[e]); } }
                    u32x4 w; w.x = cvt_pk_bf16(v0[0], v0[1]); w.y = cvt_pk_bf16(v0[2], v0[3]); w.z = cvt_pk_bf16(v1[0], v1[1]); w.w = cvt_pk_bf16(v1[2], v1[3]);
                    *(u32x4*)(rowp + bj * HALF) = w; } }
    }
};
struct EpiF8x8 {
    static constexpr bool PERM = true;
    unsigned char* O; int ldc;
    __device__ __forceinline__ void operator()(const Acc& acc, const Unit& u, int wr, int wc, int fr, int fq) const {
        const int row0 = u.pm * BM + wr * 64 + fr, col0 = u.pn * BM + wc * 32 + 8 * fq;
#pragma unroll
        for (int ai = 0; ai < 2; ++ai)
#pragma unroll
            for (int m = 0; m < 4; ++m) { unsigned char* rowp = O + (size_t)(row0 + ai * HALF + m * 16) * ldc + col0;
#pragma unroll
                for (int bj = 0; bj < 2; ++bj) { const f32x4 v0 = acc[ai][bj][m][0] * 8.0f, v1 = acc[ai][bj][m][1] * 8.0f;
                    u32x2 w = {0u, 0u}; w.x = __builtin_amdgcn_cvt_pk_fp8_f32(v0[0], v0[1], w.x, false); w.x = __builtin_amdgcn_cvt_pk_fp8_f32(v0[2], v0[3], w.x, true);
                    w.y = __builtin_amdgcn_cvt_pk_fp8_f32(v1[0], v1[1], w.y, false); w.y = __builtin_amdgcn_cvt_pk_fp8_f32(v1[2], v1[3], w.y, true);
                    *(u32x2*)(rowp + bj * HALF) = w; } }
    }
};
template <int MODE, bool O8 = false, bool P8 = false> struct EpiGate {
    static constexpr bool PERM = true;
    const bf16_t* __restrict__ G; const bf16_t* __restrict__ P; bf16_t* __restrict__ O;
    __device__ __forceinline__ void operator()(const Acc& acc, const Unit& u, int wr, int wc, int fr, int fq) const {
        const int row0 = u.pm * BM + wr * 64 + fr, col0 = u.pn * BM + wc * 32 + 8 * fq;
#pragma unroll
        for (int ai = 0; ai < 2; ++ai) {
            u32x4 g[4][2], p[4][2]; u32x2 p8[4][2];
#pragma unroll
            for (int m = 0; m < 4; ++m)
#pragma unroll
                for (int bj = 0; bj < 2; ++bj) { const size_t ro = (size_t)(row0 + ai * HALF + m * 16) * 1024 + col0 + bj * HALF; g[m][bj] = *(const u32x4*)(G + ro); if (MODE == 1) { if constexpr (P8) p8[m][bj] = *(const u32x2*)((const unsigned char*)P + ro); else p[m][bj] = *(const u32x4*)(P + ro); } }
#pragma unroll
            for (int m = 0; m < 4; ++m)
#pragma unroll
                for (int bj = 0; bj < 2; ++bj) { const size_t ro = (size_t)(row0 + ai * HALF + m * 16) * 1024 + col0 + bj * HALF; const f32x4 v0 = acc[ai][bj][m][0], v1 = acc[ai][bj][m][1]; const u32x4 gg = g[m][bj];
                    float o[8];
                    o[0] = bflo(gg.x) * v0[0]; o[1] = bfhi(gg.x) * v0[1]; o[2] = bflo(gg.y) * v0[2]; o[3] = bfhi(gg.y) * v0[3];
                    o[4] = bflo(gg.z) * v1[0]; o[5] = bfhi(gg.z) * v1[1]; o[6] = bflo(gg.w) * v1[2]; o[7] = bfhi(gg.w) * v1[3];
                    if (MODE == 1) {
                        if constexpr (P8) { const u32x2 pq = p8[m][bj]; const f32x2 a_ = __builtin_amdgcn_cvt_pk_f32_fp8(pq.x, false), b_ = __builtin_amdgcn_cvt_pk_f32_fp8(pq.x, true), c_ = __builtin_amdgcn_cvt_pk_f32_fp8(pq.y, false), d_ = __builtin_amdgcn_cvt_pk_f32_fp8(pq.y, true);
                            o[0] += a_[0] * 0.0625f; o[1] += a_[1] * 0.0625f; o[2] += b_[0] * 0.0625f; o[3] += b_[1] * 0.0625f; o[4] += c_[0] * 0.0625f; o[5] += c_[1] * 0.0625f; o[6] += d_[0] * 0.0625f; o[7] += d_[1] * 0.0625f; }
                        else { const u32x4 pp = p[m][bj];
                        o[0] += bflo(pp.x); o[1] += bfhi(pp.x); o[2] += bflo(pp.y); o[3] += bfhi(pp.y); o[4] += bflo(pp.z); o[5] += bfhi(pp.z); o[6] += bflo(pp.w); o[7] += bfhi(pp.w); } }
                    if constexpr (O8 && MODE == 0) {
#pragma unroll
                        for (int e_ = 0; e_ < 8; ++e_) o[e_] *= 16.0f; }
                    if constexpr (O8) { u32x2 w8 = {0u, 0u}; w8.x = __builtin_amdgcn_cvt_pk_fp8_f32(o[0], o[1], w8.x, false); w8.x = __builtin_amdgcn_cvt_pk_fp8_f32(o[2], o[3], w8.x, true);
                        w8.y = __builtin_amdgcn_cvt_pk_fp8_f32(o[4], o[5], w8.y, false); w8.y = __builtin_amdgcn_cvt_pk_fp8_f32(o[6], o[7], w8.y, true); *(u32x2*)((unsigned char*)O + ro) = w8; }
                    else {
                    u32x4 w; w.x = cvt_pk_bf16(o[0], o[1]); w.y = cvt_pk_bf16(o[2], o[3]); w.z = cvt_pk_bf16(o[4], o[5]); w.w = cvt_pk_bf16(o[6], o[7]);
                    *(u32x4*)(O + ro) = w; } }
        }
    }
};
struct EpiResid {
    static constexpr bool PERM = true;
    const float* __restrict__ X; bf16_t* __restrict__ H;
    __device__ __forceinline__ void operator()(const Acc& acc, const Unit& u, int wr, int wc, int fr, int fq) const {
        const int row0 = u.pm * BM + wr * 64 + fr, col0 = u.pn * BM + wc * 32 + 8 * fq;
#pragma unroll
        for (int ai = 0; ai < 2; ++ai) {
            f32x4 xv[4][2][2];
#pragma unroll
            for (int m = 0; m < 4; ++m)
#pragma unroll
                for (int bj = 0; bj < 2; ++bj)
#pragma unroll
                    for (int n = 0; n < 2; ++n) xv[m][bj][n] = *(const f32x4*)(X + (size_t)(row0 + ai * HALF + m * 16) * 1024 + col0 + bj * HALF + n * 4);
#pragma unroll
            for (int m = 0; m < 4; ++m)
#pragma unroll
                for (int bj = 0; bj < 2; ++bj) { const size_t o = (size_t)(row0 + ai * HALF + m * 16) * 1024 + col0 + bj * HALF; const f32x4 v0 = xv[m][bj][0] + acc[ai][bj][m][0], v1 = xv[m][bj][1] + acc[ai][bj][m][1];
                    u32x4 w; w.x = cvt_pk_bf16(v0[0], v0[1]); w.y = cvt_pk_bf16(v0[2], v0[3]); w.z = cvt_pk_bf16(v1[0], v1[1]); w.w = cvt_pk_bf16(v1[2], v1[3]);
                    *(u32x4*)(H + o) = w; }
        }
    }
};
struct EpiSwiglu {
    static constexpr bool PERM = true;
    const PG8_LAS int* t2e; const float* bgu; unsigned char* ACT; const float* srs;
    __device__ __forceinline__ void operator()(const Acc& acc, const Unit& u, int wr, int wc, int fr, int fq) const {
        const int e = __builtin_amdgcn_readfirstlane(t2e[u.pm]); const int row0 = u.pm * BM + wr * 64 + fr, j0 = u.pn * 128 + wc * 32 + 8 * fq;
        const float* bg = bgu + (size_t)e * 2048 + j0; const float* bu = bg + 1024;
        const f32x4 bg0 = *(const f32x4*)bg, bg1 = *(const f32x4*)(bg + 4), bu0 = *(const f32x4*)bu, bu1 = *(const f32x4*)(bu + 4);
        float rsv[2][4];
#pragma unroll
        for (int ai = 0; ai < 2; ++ai)
#pragma unroll
            for (int m = 0; m < 4; ++m) rsv[ai][m] = srs[row0 + ai * HALF + m * 16];
#pragma unroll
        for (int ai = 0; ai < 2; ++ai)
#pragma unroll
            for (int m = 0; m < 4; ++m) { const int row = row0 + ai * HALF + m * 16; const float sc = F8_ACC_SCALE * rsv[ai][m];
                float o[8];
#pragma unroll
                for (int n = 0; n < 2; ++n)
#pragma unroll
                    for (int q = 0; q < 4; ++q) { float gt = acc[ai][0][m][n][q] * sc + (n ? bg1[q] : bg0[q]); float up = acc[ai][1][m][n][q] * sc + (n ? bu1[q] : bu0[q]);
                        gt = fminf(gt, 7.0f); up = fminf(fmaxf(up, -7.0f), 7.0f); o[n * 4 + q] = (up + 1.0f) * (gt * sigmoidf_(1.702f * gt)); }
                u32x2 w = {0u, 0u}; w.x = __builtin_amdgcn_cvt_pk_fp8_f32(o[0], o[1], w.x, false); w.x = __builtin_amdgcn_cvt_pk_fp8_f32(o[2], o[3], w.x, true);
                w.y = __builtin_amdgcn_cvt_pk_fp8_f32(o[4], o[5], w.y, false); w.y = __builtin_amdgcn_cvt_pk_fp8_f32(o[6], o[7], w.y, true);
                *(u32x2*)(ACT + (size_t)row * 1024 + j0) = w; }
    }
};
struct EpiDown {
    static constexpr bool PERM = true;
    const PG8_LAS int* t2e; const float* bdn; const u32x2* smeta; unsigned char* Y;
    __device__ __forceinline__ void operator()(const Acc& acc, const Unit& u, int wr, int wc, int fr, int fq) const {
        const int e = __builtin_amdgcn_readfirstlane(t2e[u.pm]); const int row0 = u.pm * BM + wr * 64 + fr, col0 = u.pn * BM + wc * 32 + 8 * fq;
        f32x4 bv[2][2];
#pragma unroll
        for (int bj = 0; bj < 2; ++bj)
#pragma unroll
            for (int n = 0; n < 2; ++n) bv[bj][n] = *(const f32x4*)(bdn + (size_t)e * 1024 + col0 + bj * HALF + 4 * n);
        int tkv[2][4]; float gtv[2][4];
#pragma unroll
        for (int ai = 0; ai < 2; ++ai)
#pragma unroll
            for (int m = 0; m < 4; ++m) { const u32x2 mt = smeta[row0 + ai * HALF + m * 16]; tkv[ai][m] = (int)mt.x; gtv[ai][m] = __uint_as_float(mt.y); }
#pragma unroll
        for (int ai = 0; ai < 2; ++ai)
#pragma unroll
            for (int m = 0; m < 4; ++m) { const int tk = tkv[ai][m]; const float gt = gtv[ai][m];
                if (tk >= 0) { unsigned char* rowp = Y + (size_t)tk * 1024 + col0; const float g16 = gt * 16.0f;
#pragma unroll
                    for (int bj = 0; bj < 2; ++bj) { const f32x4 v0 = (acc[ai][bj][m][0] * F8_ACC_SCALE + bv[bj][0]) * g16, v1 = (acc[ai][bj][m][1] * F8_ACC_SCALE + bv[bj][1]) * g16;
                        u32x2 w = {0u, 0u}; w.x = __builtin_amdgcn_cvt_pk_fp8_f32(v0[0], v0[1], w.x, false); w.x = __builtin_amdgcn_cvt_pk_fp8_f32(v0[2], v0[3], w.x, true);
                        w.y = __builtin_amdgcn_cvt_pk_fp8_f32(v1[0], v1[1], w.y, false); w.y = __builtin_amdgcn_cvt_pk_fp8_f32(v1[2], v1[3], w.y, true);
                        *(u32x2*)(rowp + bj * HALF) = w; } } }
    }
};
struct EpiPle {
    static constexpr bool PERM = false;
    float* __restrict__ OUT; const float* __restrict__ rstd; const unsigned char* __restrict__ PP; const bf16_t* __restrict__ H2;
    __device__ __forceinline__ void operator()(const Acc& acc, const Unit& u, int wr, int wc, int fr, int fq) const {
        const int row0 = u.pm * BM + wr * 64 + fr, col0 = u.pn * BM + wc * 32 + 4 * fq;
        float rsv[2][4];
#pragma unroll
        for (int ai = 0; ai < 2; ++ai)
#pragma unroll
            for (int m = 0; m < 4; ++m) rsv[ai][m] = rstd[row0 + ai * HALF + m * 16];
#pragma unroll
        for (int ai = 0; ai < 2; ++ai) {
            u32x2 hv[4][2][2]; unsigned pv[4][2][2];
#pragma unroll
            for (int m = 0; m < 4; ++m)
#pragma unroll
                for (int bj = 0; bj < 2; ++bj)
#pragma unroll
                    for (int n = 0; n < 2; ++n) { const size_t o = (size_t)(row0 + ai * HALF + m * 16) * 1024 + col0 + bj * HALF + n * 16; hv[m][bj][n] = *(const u32x2*)(H2 + o); pv[m][bj][n] = *(const unsigned*)(PP + o); }
#pragma unroll
            for (int m = 0; m < 4; ++m)
#pragma unroll
                for (int bj = 0; bj < 2; ++bj)
#pragma unroll
                    for (int n = 0; n < 2; ++n) { const size_t o = (size_t)(row0 + ai * HALF + m * 16) * 1024 + col0 + bj * HALF + n * 16; const u32x2 h = hv[m][bj][n]; const unsigned p = pv[m][bj][n]; const f32x4 a = acc[ai][bj][m][n]; const float rs = rsv[ai][m];
                        const f32x2 p01 = __builtin_amdgcn_cvt_pk_f32_fp8(p, false), p23 = __builtin_amdgcn_cvt_pk_f32_fp8(p, true);
                        f32x4 r; r[0] = bflo(h.x) + sigmoidf_(a[0] * rs) * (p01[0] * 0.125f); r[1] = bfhi(h.x) + sigmoidf_(a[1] * rs) * (p01[1] * 0.125f); r[2] = bflo(h.y) + sigmoidf_(a[2] * rs) * (p23[0] * 0.125f); r[3] = bfhi(h.y) + sigmoidf_(a[3] * rs) * (p23[1] * 0.125f);
                        *(f32x4*)(OUT + o) = r; }
        }
    }
};
}

namespace attn {
constexpr int D = 128, NW = 8, QBLK = 32, KVBLK = 64;
constexpr float SCALE = 0.088388347648318440f;
constexpr float THR = 8.f;
constexpr int SDEPTH = 1;
constexpr int LDQ = 1024, LDK = 256, LDO = 1024;
constexpr size_t SHM_V = KVBLK * D * 2, SHM_K = KVBLK * D * 2, SHM_ATTN = 2 * SHM_V + 2 * SHM_K + NW * 64 * 4;
#define KSWZ(row, colB) ((row) * 256 + ((colB) ^ (((row) & 7) << 4)))
#define SBAR() __builtin_amdgcn_sched_barrier(0)
__device__ __forceinline__ int crow(int r, int hi) { return (r & 3) + 8 * (r >> 2) + 4 * hi; }
__device__ __forceinline__ unsigned cvtpk(float lo, float hi) { unsigned r; asm volatile("v_cvt_pk_bf16_f32 %0, %1, %2" : "=v"(r) : "v"(lo), "v"(hi)); return r; }
__device__ __forceinline__ void partialSM(f32x16& p0, f32x16& p1, float& m_reg, float& mn, float& alpha) {
  constexpr float C = SCALE * 1.4426950408889634f;
  float pmax = p0[0]; for (int r = 1; r < 16; ++r) pmax = fmaxf(pmax, p0[r]); for (int r = 0; r < 16; ++r) pmax = fmaxf(pmax, p1[r]);
  { auto rr = __builtin_amdgcn_permlane32_swap(__float_as_uint(pmax), __float_as_uint(pmax), false, false);
    pmax = fmaxf(__uint_as_float(rr[0]), __uint_as_float(rr[1])); }
  if (__builtin_expect(__all(pmax - m_reg <= THR / SCALE), 1)) { mn = m_reg; alpha = 1.f; }
  else { mn = fmaxf(m_reg, pmax); alpha = __builtin_amdgcn_exp2f((m_reg - mn) * C); m_reg = mn; }
  float mnC = -mn * C;
  for (int r = 0; r < 16; ++r) p0[r] = fmaf(p0[r], C, mnC); for (int r = 0; r < 16; ++r) p1[r] = fmaf(p1[r], C, mnC);
  for (int r = 0; r < 16; ++r) p0[r] = __builtin_amdgcn_exp2f(p0[r]);
}
__device__ __forceinline__ void finishSM(f32x16& p0, f32x16& p1, float alpha, float& l_reg, bf16x8& pa0, bf16x8& pa1, bf16x8& pa2, bf16x8& pa3) {
  for (int r = 0; r < 16; ++r) p1[r] = __builtin_amdgcn_exp2f(p1[r]);
  float ps = 0; for (int r = 0; r < 16; ++r) ps += p0[r]; for (int r = 0; r < 16; ++r) ps += p1[r];
  { auto rr = __builtin_amdgcn_permlane32_swap(__float_as_uint(ps), __float_as_uint(ps), false, false);
    ps = __uint_as_float(rr[0]) + __uint_as_float(rr[1]); }
  l_reg = l_reg * alpha + ps;
#define PK4(P, BASE, OUT) do { unsigned a0 = cvtpk(P[BASE + 0], P[BASE + 1]), a1 = cvtpk(P[BASE + 2], P[BASE + 3]);   \
    unsigned b0 = cvtpk(P[BASE + 4], P[BASE + 5]), b1 = cvtpk(P[BASE + 6], P[BASE + 7]);                              \
    auto r0 = __builtin_amdgcn_permlane32_swap(a0, b0, false, false); auto r1 = __builtin_amdgcn_permlane32_swap(a1, b1, false, false); \
    u32x4 w = {r0[0], r1[0], r0[1], r1[1]}; OUT = *reinterpret_cast<bf16x8*>(&w); } while (0)
  PK4(p0, 0, pa0); PK4(p0, 8, pa1); PK4(p1, 0, pa2); PK4(p1, 8, pa3);
#undef PK4
}
__device__ __forceinline__ void qkt(f32x16& p0, f32x16& p1, const bf16* Ks, const bf16x8* qr, int r32, int hi) {
  p0 = f32x16{}; p1 = f32x16{};
  for (int d0 = 0; d0 < 8; ++d0) { int cb = (d0 * 16 + hi * 8) * 2;
    bf16x8 b0 = *reinterpret_cast<const bf16x8*>((const char*)Ks + KSWZ(r32, cb));
    bf16x8 b1 = *reinterpret_cast<const bf16x8*>((const char*)Ks + KSWZ(32 + r32, cb));
    p0 = __builtin_amdgcn_mfma_f32_32x32x16_bf16(b0, qr[d0], p0, 0, 0, 0);
    p1 = __builtin_amdgcn_mfma_f32_32x32x16_bf16(b1, qr[d0], p1, 0, 0, 0); }
}
__device__ __forceinline__ int v_st(int k, int c) { const int kk = (k & ~0xC) | ((k & 4) << 1) | ((k & 8) >> 1); return ((kk >> 3) * 4 + (c >> 5)) * 512 + ((kk & 7) * 32 + (c & 31)) * 2; }
__device__ __forceinline__ int v_rd_base(int lane) { return ((lane & 3) << 3) | (((lane >> 2) & 3) << 6) | (((lane >> 4) & 1) << 5) | (((lane >> 5) & 1) << 8); }
constexpr int v_rd_off(int d0, int ks, int half) { return d0 * 512 + ks * 4096 + half * 2048; }
template <int OFF> __device__ __forceinline__ s16x4 tr_read(int vb) {
  s16x4 r; asm volatile("ds_read_b64_tr_b16 %0, %1 offset:%2" : "=&v"(r) : "v"(vb), "i"(OFF) : "memory"); return r;
}
template <int D0> __device__ __forceinline__ void pv_one(f32x16& od, int vb, bf16x8 pa0, bf16x8 pa1, bf16x8 pa2, bf16x8 pa3) {
  const s16x4 l0 = tr_read<v_rd_off(D0, 0, 0)>(vb), h0 = tr_read<v_rd_off(D0, 0, 1)>(vb), l1 = tr_read<v_rd_off(D0, 1, 0)>(vb), h1 = tr_read<v_rd_off(D0, 1, 1)>(vb);
  const s16x4 l2 = tr_read<v_rd_off(D0, 2, 0)>(vb), h2 = tr_read<v_rd_off(D0, 2, 1)>(vb), l3 = tr_read<v_rd_off(D0, 3, 0)>(vb), h3 = tr_read<v_rd_off(D0, 3, 1)>(vb);
  asm volatile("s_waitcnt lgkmcnt(0)" ::: "memory"); SBAR();
#define PK(L, H) (bf16x8){L[0], L[1], L[2], L[3], H[0], H[1], H[2], H[3]}
  od = __builtin_amdgcn_mfma_f32_32x32x16_bf16(pa0, PK(l0, h0), od, 0, 0, 0);
  od = __builtin_amdgcn_mfma_f32_32x32x16_bf16(pa1, PK(l1, h1), od, 0, 0, 0);
  od = __builtin_amdgcn_mfma_f32_32x32x16_bf16(pa2, PK(l2, h2), od, 0, 0, 0);
  od = __builtin_amdgcn_mfma_f32_32x32x16_bf16(pa3, PK(l3, h3), od, 0, 0, 0);
#undef PK
}
__device__ __forceinline__ void pv_d0(f32x16* o, int vb, bf16x8 pa0, bf16x8 pa1, bf16x8 pa2, bf16x8 pa3) {
  pv_one<0>(o[0], vb, pa0, pa1, pa2, pa3); pv_one<1>(o[1], vb, pa0, pa1, pa2, pa3); pv_one<2>(o[2], vb, pa0, pa1, pa2, pa3); pv_one<3>(o[3], vb, pa0, pa1, pa2, pa3);
}
__device__ __forceinline__ void build_rope_table(float* tab, int tid) {
    for (int i = tid; i < 64 * 32; i += 512) { const int id = i >> 5, j = i & 31; const float inv = powf(10000.0f, -(float)(2 * j) / 64.0f); float sn, cs; sincosf((float)id * inv, &sn, &cs); tab[2 * i] = cs; tab[2 * i + 1] = sn; }
}
__device__ __forceinline__ void attn_dense_body(const bf16* Qb, const bf16* __restrict__ Kh, const bf16* __restrict__ Vh, unsigned char* Ob, int seq, char* lds, const float* qn, const float* rtab, int s0) {
  const int tid = threadIdx.x, wid = tid >> 6, lane = tid & 63, r32 = lane & 31, hi = lane >> 5;
  bf16* V_lds = (bf16*)lds; bf16* K_lds = (bf16*)(lds + 2 * SHM_V);
  float* ws = (float*)(lds + 2 * SHM_V + 2 * SHM_K) + wid * 64; float* li_l = ws; float* al_l = ws + 32;
  const int sr = tid >> 4, sc = (tid & 15) * 8, vst0 = v_st(sr, sc), vst1 = vst0 + 8192;
  const unsigned toff = (unsigned)((sr * LDK + sc) * 2);
  const int vb0 = (int)(uintptr_t)V_lds + v_rd_base(lane);
  struct { bf16x8 vs0, vs1, ks0, ks1; } sr_[SDEPTH];
#define SLOAD(i, k0) do { const char* vb_ = (const char*)Vh + (size_t)(k0) * (LDK * 2); const char* kb_ = (const char*)Kh + (size_t)(k0) * (LDK * 2); \
    sr_[i].vs0 = *reinterpret_cast<const bf16x8*>(vb_ + toff); sr_[i].vs1 = *reinterpret_cast<const bf16x8*>(vb_ + 32 * LDK * 2 + toff); \
    sr_[i].ks0 = *reinterpret_cast<const bf16x8*>(kb_ + toff); sr_[i].ks1 = *reinterpret_cast<const bf16x8*>(kb_ + 32 * LDK * 2 + toff); } while (0)
  SLOAD(0, 0);
  float m_reg = -1e30f, l_reg = 0; f32x16 o[4] = {}; bf16x8 qr[8];
  const bf16* Qw = Qb + (long)(wid * QBLK + r32) * LDQ + hi * 8;
#pragma unroll
  for (int d0 = 0; d0 < 8; ++d0) qr[d0] = *reinterpret_cast<const bf16x8*>(Qw + d0 * 16);
  {
    float x[8][8]; float ss = 0.f;
#pragma unroll
    for (int d0 = 0; d0 < 8; ++d0) { const u32x4 w = *reinterpret_cast<const u32x4*>(&qr[d0]);
      x[d0][0] = bflo(w.x); x[d0][1] = bfhi(w.x); x[d0][2] = bflo(w.y); x[d0][3] = bfhi(w.y); x[d0][4] = bflo(w.z); x[d0][5] = bfhi(w.z); x[d0][6] = bflo(w.w); x[d0][7] = bfhi(w.w);
#pragma unroll
      for (int j = 0; j < 8; ++j) ss += x[d0][j] * x[d0][j]; }
    { auto rr = __builtin_amdgcn_permlane32_swap(__float_as_uint(ss), __float_as_uint(ss), false, false); ss = __uint_as_float(rr[0]) + __uint_as_float(rr[1]); }
    const float rstd = 1.0f / sqrtf(ss * (1.f / 128.f) + 1e-6f);
#pragma unroll
    for (int d0 = 0; d0 < 8; ++d0) { const f32x4 g0 = *(const f32x4*)(qn + d0 * 16 + hi * 8), g1 = *(const f32x4*)(qn + d0 * 16 + hi * 8 + 4);
#pragma unroll
      for (int j = 0; j < 4; ++j) { x[d0][j] *= rstd * g0[j]; x[d0][4 + j] *= rstd * g1[j]; } }
    const int spos = s0 + wid * QBLK + r32, rid = spos >> 6, cid = spos & 63;
#pragma unroll
    for (int pr = 0; pr < 4; ++pr) { const int a = (pr & 1) + 4 * (pr >> 1), b = a + 2; const int id = (pr >> 1) ? cid : rid; const float* tp = rtab + 2 * (id * 32 + (pr & 1) * 16 + hi * 8);
      f32x4 t[4];
#pragma unroll
      for (int q = 0; q < 4; ++q) t[q] = *(const f32x4*)(tp + 4 * q);
#pragma unroll
      for (int j = 0; j < 8; ++j) { const float cs = t[j >> 1][(j & 1) * 2], sn = t[j >> 1][(j & 1) * 2 + 1]; const float xa = x[a][j], xb = x[b][j]; x[a][j] = xa * cs - xb * sn; x[b][j] = xb * cs + xa * sn; } }
#pragma unroll
    for (int d0 = 0; d0 < 8; ++d0) { u32x4 w = {cvtpk(x[d0][0], x[d0][1]), cvtpk(x[d0][2], x[d0][3]), cvtpk(x[d0][4], x[d0][5]), cvtpk(x[d0][6], x[d0][7])}; qr[d0] = *reinterpret_cast<bf16x8*>(&w); asm volatile("" : "+v"(qr[d0])); } }
#define SWRITE(b, i) do { *(bf16x8*)((char*)V_lds + (b) * SHM_V + vst0) = sr_[i].vs0;          \
    *(bf16x8*)((char*)V_lds + (b) * SHM_V + vst1) = sr_[i].vs1; int kc = sc * 2;               \
    *(bf16x8*)((char*)K_lds + (b) * SHM_K + KSWZ(sr, kc)) = sr_[i].ks0;                       \
    *(bf16x8*)((char*)K_lds + (b) * SHM_K + KSWZ(sr, kc) + 8192) = sr_[i].ks1; } while (0)
#define SWAIT() do { if constexpr (SDEPTH == 2) asm volatile("s_waitcnt vmcnt(4)" ::: "memory"); else asm volatile("s_waitcnt vmcnt(0)" ::: "memory"); } while (0)
#define RESC(a) do { if (__any((a) < 1.f)) { if (hi == 0) al_l[r32] = (a); asm volatile("s_waitcnt lgkmcnt(0)" ::: "memory"); \
    for (int d = 0; d < 4; ++d) for (int r = 0; r < 16; ++r) o[d][r] *= al_l[crow(r, hi)]; } } while (0)
  f32x16 pA0, pA1, pB0, pB1; float mnA, mnB, alA, alB; bf16x8 pa0, pa1, pa2, pa3; const int NT = seq / KVBLK;
  constexpr int SE = 0, SO = SDEPTH - 1;
  asm volatile("s_waitcnt vmcnt(0)" ::: "memory"); SWRITE(0, SE); __syncthreads();
  qkt(pA0, pA1, K_lds, qr, r32, hi); partialSM(pA0, pA1, m_reg, mnA, alA);
  SLOAD(SO, KVBLK); if constexpr (SDEPTH == 2) { if (2 < NT) SLOAD(SE, 2 * KVBLK); }
  SWAIT(); SWRITE(1, SO); __syncthreads();
  for (int j = 1; j + 1 < NT; j += 2) {
    SBAR(); qkt(pB0, pB1, (bf16*)((char*)K_lds + SHM_K), qr, r32, hi);
    finishSM(pA0, pA1, alA, l_reg, pa0, pa1, pa2, pa3); SBAR();
    SLOAD(SO, (j + SDEPTH) * KVBLK); SBAR();
    pv_d0(o, vb0, pa0, pa1, pa2, pa3); partialSM(pB0, pB1, m_reg, mnB, alB);
    __syncthreads(); SWAIT(); SWRITE(0, SE);
    RESC(alB); __syncthreads();
    SBAR(); qkt(pA0, pA1, K_lds, qr, r32, hi);
    finishSM(pB0, pB1, alB, l_reg, pa0, pa1, pa2, pa3); SBAR();
    if (SDEPTH == 1 || j + 3 < NT) SLOAD(SE, (j + 1 + SDEPTH) * KVBLK); SBAR();
    pv_d0(o, vb0 + (int)SHM_V, pa0, pa1, pa2, pa3); partialSM(pA0, pA1, m_reg, mnA, alA);
    __syncthreads(); SWAIT(); SWRITE(1, SO);
    RESC(alA); __syncthreads();
  }
  SBAR(); qkt(pB0, pB1, (bf16*)((char*)K_lds + SHM_K), qr, r32, hi);
  finishSM(pA0, pA1, alA, l_reg, pa0, pa1, pa2, pa3); SBAR();
  pv_d0(o, vb0, pa0, pa1, pa2, pa3); partialSM(pB0, pB1, m_reg, mnB, alB);
  __syncthreads(); RESC(alB);
  finishSM(pB0, pB1, alB, l_reg, pa0, pa1, pa2, pa3); SBAR();
  pv_d0(o, vb0 + (int)SHM_V, pa0, pa1, pa2, pa3);
  if (hi == 0) li_l[r32] = l_reg; asm volatile("s_waitcnt lgkmcnt(0)" ::: "memory");
  float rli[16];
#pragma unroll
  for (int r = 0; r < 16; ++r) rli[r] = __builtin_amdgcn_rcpf(li_l[crow(r, hi)]);
  unsigned char* Ow = Ob + (long)(wid * QBLK) * LDO;
#pragma unroll
  for (int r = 0; r < 16; ++r) { int orow = crow(r, hi);
    for (int d0 = 0; d0 < 4; ++d0) { const float v_ = o[d0][r] * rli[r]; Ow[(long)orow * LDO + d0 * 32 + r32] = (unsigned char)__builtin_amdgcn_cvt_pk_fp8_f32(v_, v_, 0u, false); } }
  __syncthreads();
#undef SLOAD
#undef SWRITE
#undef SWAIT
#undef RESC
}
}

#define XB_TMO      128
#define XB_XCNT(j)  (256  + 64 * (j))
#define XB_XSUB(j)  (1280 + 64 * (j))
#define XB_XGEN(j)  (2304 + 64 * (j))
#define XB_TOP      3328
#define XB_TOPGEN   3392
#define XCD_BAR_WORDS 3456
#define XB_SPIN_CAP (1u << 18)
__device__ __forceinline__ unsigned xb_ld(unsigned* p)              { return __hip_atomic_load(p, __ATOMIC_RELAXED, __HIP_MEMORY_SCOPE_AGENT); }
__device__ __forceinline__ unsigned xb_add(unsigned* p, unsigned v) { return __hip_atomic_fetch_add(p, v, __ATOMIC_RELAXED, __HIP_MEMORY_SCOPE_AGENT); }
__device__ __forceinline__ unsigned xb_xcc_id() { return (unsigned)__builtin_amdgcn_s_getreg((3 << 11) | 20) & 0xFu; }
#define XB_SPIN(cond, bar) do { unsigned _sp = 0; while (cond) { __builtin_amdgcn_s_sleep(1); \
    if ((++_sp & 255u) == 0u) { if (xb_ld(&(bar)[XB_TMO])) break; if (_sp > XB_SPIN_CAP) { atomicAdd(&(bar)[XB_TMO], 1u); break; } } } } while (0)
struct XcdBarrier { unsigned* bar; unsigned x; volatile LAS unsigned* st; };
__device__ __forceinline__ XcdBarrier xcd_barrier_post(unsigned* bar, volatile LAS unsigned* st) {
    XcdBarrier b; b.bar = bar; b.x = xb_xcc_id(); b.st = st;
    if (threadIdx.x == 0) (void)xb_add(&bar[XB_XCNT(b.x)], 1u);
    return b;
}
__device__ __forceinline__ void xcd_barrier_complete(unsigned* bar, unsigned x, unsigned& nloc, unsigned& nx) {
    const unsigned G = gridDim.x * gridDim.y * gridDim.z;
    unsigned sum, cnt, mine, sp = 0u;
    for (;;) {
        sum = 0u; cnt = 0u; mine = 0u;
#pragma unroll
        for (unsigned j = 0; j < 16; ++j) { const unsigned c = xb_ld(&bar[XB_XCNT(j)]); sum += c; cnt += (c > 0u) ? 1u : 0u; mine = (j == x) ? c : mine; }
        if (sum == G) break;
        __builtin_amdgcn_s_sleep(1);
        if ((++sp & 255u) == 0u) { if (xb_ld(&bar[XB_TMO])) break; if (sp > XB_SPIN_CAP) { atomicAdd(&bar[XB_TMO], 1u); break; } }
    }
    nloc = mine > 0u ? mine : 1u; nx = cnt > 0u ? cnt : 1u;
}
__device__ __forceinline__ void xcd_barrier(const XcdBarrier& b) {
    asm volatile("s_waitcnt vmcnt(0)" ::: "memory");
    __syncthreads();
    if (threadIdx.x == 0) {
        unsigned* bar = b.bar;
        __builtin_amdgcn_s_waitcnt(0);
        unsigned nloc = b.st[0], nx = b.st[1];
        if (nloc == 0u) { xcd_barrier_complete(bar, b.x, nloc, nx); b.st[0] = nloc; b.st[1] = nx; }
        const unsigned old = xb_add(&bar[XB_XSUB(b.x)], 1u);
        const unsigned gen = old / nloc;
        if (old + 1u == (gen + 1u) * nloc) {
            __builtin_amdgcn_fence(__ATOMIC_RELEASE, "agent");
            asm volatile("s_waitcnt vmcnt(0)" ::: "memory");
            const unsigned og = xb_add(&bar[XB_TOP], 1u);
            const unsigned tg = og / nx;
            if (og + 1u == (tg + 1u) * nx) xb_add(&bar[XB_TOPGEN], 1u);
            else XB_SPIN(xb_ld(&bar[XB_TOPGEN]) == tg, bar);
            __builtin_amdgcn_fence(__ATOMIC_ACQUIRE, "agent");
            xb_add(&bar[XB_XGEN(b.x)], 1u);
            asm volatile("s_waitcnt vmcnt(0)" ::: "memory");
        } else {
            XB_SPIN(xb_ld(&bar[XB_XGEN(b.x)]) == gen, bar);
            __builtin_amdgcn_fence(__ATOMIC_ACQUIRE, "agent");
            asm volatile("s_waitcnt vmcnt(0)" ::: "memory");
        }
    }
    __syncthreads();
}

struct Args {
    const float* in[26];
    float* out; unsigned char* ws;
    int ph_lo, ph_hi, use_bar, pad;
};
enum { I_X = 0, I_P, I_GMIX, I_WIN, I_QN, I_KN, I_CONVW, I_CONVB, I_LWA, I_LBA, I_LWI, I_LBI, I_LAM, I_WABR, I_WLBR, I_WOUT, I_GMOE, I_WR, I_BR, I_WGU, I_BGU, I_WDN, I_BDN, I_GPLE, I_WPG, I_WPP };

struct Frame {
    LAS unsigned char* lds; char* lds_g;
    int tid, lane, wave, G, c;
    const Args* a;
};

template <class Map>
__device__ __forceinline__ void p0_transpose_item(const float* W, int K, int N, bf16* WT, const float* gain, LAS float* scr, int item, int lane, const Map& map) {
    const int nblk = N / 64, kb = item / nblk, nb = item % nblk, k0 = 64 * kb, n0 = 64 * nb;
#pragma unroll 4
    for (int it = 0; it < 16; ++it) { const int kk = 4 * it + (lane >> 4), nn = 4 * (lane & 15);
        f32x4 v = *(const f32x4*)(W + (size_t)(k0 + kk) * N + n0 + nn);
        if (gain) v = v * gain[k0 + kk];
        LAS float* d = scr + kk * 65 + nn; d[0] = v[0]; d[1] = v[1]; d[2] = v[2]; d[3] = v[3]; }
    LDS_WAIT(); asm volatile("" ::: "memory");
    const int c = lane & 7;
#pragma unroll
    for (int j = 0; j < 8; ++j) { const int n = (lane >> 3) + 8 * j; const LAS float* s = scr + (8 * c) * 65 + n;
        u32x4 o; o.x = pk2(s[0 * 65], s[1 * 65]); o.y = pk2(s[2 * 65], s[3 * 65]); o.z = pk2(s[4 * 65], s[5 * 65]); o.w = pk2(s[6 * 65], s[7 * 65]);
        *(u32x4*)(WT + (size_t)map(n0 + n) * K + k0 + 8 * c) = o; }
    LDS_WAIT(); asm volatile("" ::: "memory");
}
struct MapId { __device__ __forceinline__ int operator()(int n) const { return n; } };
struct MapWinF8 { __device__ __forceinline__ int operator()(int n) const { return n < 1536 ? n : n - 2048; } };
struct MapWinBf { __device__ __forceinline__ int operator()(int n) const { return n + 2048; } };
struct MapGU { __device__ __forceinline__ int operator()(int n) const { const int up = n >> 10, j = n & 1023; return 256 * (j >> 7) + 128 * up + (j & 127); } };
template <class Map>
__device__ __forceinline__ void p0_transpose_item_f8(const float* W, int K, int N, unsigned char* WT, const float* gain, LAS float* scr, int item, int lane, const Map& map) {
    const int nblk = N / 64, kb = item / nblk, nb = item % nblk, k0 = 64 * kb, n0 = 64 * nb;
#pragma unroll 4
    for (int it = 0; it < 16; ++it) { const int kk = 4 * it + (lane >> 4), nn = 4 * (lane & 15);
        f32x4 v = *(const f32x4*)(W + (size_t)(k0 + kk) * N + n0 + nn);
        v = v * (gain ? 32.0f * gain[k0 + kk] : 32.0f);
        LAS float* d = scr + kk * 65 + nn; d[0] = v[0]; d[1] = v[1]; d[2] = v[2]; d[3] = v[3]; }
    LDS_WAIT(); asm volatile("" ::: "memory");
    const int c = lane & 7;
#pragma unroll
    for (int j = 0; j < 8; ++j) { const int n = (lane >> 3) + 8 * j; const LAS float* s = scr + (8 * c) * 65 + n;
        u32x2 o = {0u, 0u}; o.x = __builtin_amdgcn_cvt_pk_fp8_f32(s[0 * 65], s[1 * 65], o.x, false); o.x = __builtin_amdgcn_cvt_pk_fp8_f32(s[2 * 65], s[3 * 65], o.x, true);
        o.y = __builtin_amdgcn_cvt_pk_fp8_f32(s[4 * 65], s[5 * 65], o.y, false); o.y = __builtin_amdgcn_cvt_pk_fp8_f32(s[6 * 65], s[7 * 65], o.y, true);
        *(u32x2*)(WT + (size_t)map(n0 + n) * K + k0 + 8 * c) = o; }
    LDS_WAIT(); asm volatile("" ::: "memory");
}

struct XwItem { const float* src; unsigned char* dst; const float* gain; int N, k0, n0, gu; };
__device__ __forceinline__ XwItem xw_item(const Args& A, unsigned char* ws, int it, int lane) {
    XwItem d; int r;
    if (it < NE * 512) { const int e = it >> 9; r = it & 511; d.N = 2048; d.gu = 1; d.gain = A.in[I_GMOE]; d.src = A.in[I_WGU] + (size_t)e * 1024 * 2048; d.dst = ws + WS_WGU + (size_t)e * 2048 * 1024; d.k0 = 64 * (r >> 5); d.n0 = 64 * (r & 31); }
    else { const int q = it - NE * 512, e = q >> 8; r = q & 255; d.N = 1024; d.gu = 0; d.gain = nullptr; d.src = A.in[I_WDN] + (size_t)e * 1024 * 1024; d.dst = ws + WS_WDN + (size_t)e * 1024 * 1024; d.k0 = 64 * (r >> 4); d.n0 = 64 * (r & 15); }
    d.src += (size_t)(d.k0 + (lane >> 4)) * d.N + d.n0 + 4 * (lane & 15);
    return d;
}
#define XW_LOAD(R, d) do { _Pragma("unroll") for (int i_ = 0; i_ < 16; ++i_) R[i_] = *(const f32x4*)((d).src + (size_t)(4 * i_) * (d).N); } while (0)
__device__ __forceinline__ void xw_finish(const f32x4 (&R)[16], const XwItem& d, LAS float* scr, int lane) {
#pragma unroll
    for (int it = 0; it < 16; ++it) { LAS float* p = scr + (4 * it + (lane >> 4)) * 65 + 4 * (lane & 15); p[0] = R[it][0]; p[1] = R[it][1]; p[2] = R[it][2]; p[3] = R[it][3]; }
    LDS_WAIT(); asm volatile("" ::: "memory");
    const int c = lane & 7;
    f32x4 g0 = {32.f, 32.f, 32.f, 32.f}, g1 = g0;
    if (d.gain) { g0 = *(const f32x4*)(d.gain + d.k0 + 8 * c) * 32.0f; g1 = *(const f32x4*)(d.gain + d.k0 + 8 * c + 4) * 32.0f; }
#pragma unroll
    for (int j = 0; j < 8; ++j) { const int n = (lane >> 3) + 8 * j; const LAS float* s = scr + (8 * c) * 65 + n;
        u32x2 o = {0u, 0u}; o.x = __builtin_amdgcn_cvt_pk_fp8_f32(s[0 * 65] * g0[0], s[1 * 65] * g0[1], o.x, false); o.x = __builtin_amdgcn_cvt_pk_fp8_f32(s[2 * 65] * g0[2], s[3 * 65] * g0[3], o.x, true);
        o.y = __builtin_amdgcn_cvt_pk_fp8_f32(s[4 * 65] * g1[0], s[5 * 65] * g1[1], o.y, false); o.y = __builtin_amdgcn_cvt_pk_fp8_f32(s[6 * 65] * g1[2], s[7 * 65] * g1[3], o.y, true);
        const int nn = d.n0 + n; const int row = d.gu ? MapGU()(nn) : nn;
        *(u32x2*)(d.dst + (size_t)row * 1024 + d.k0 + 8 * c) = o; }
    LDS_WAIT(); asm volatile("" ::: "memory");
}
__device__ __forceinline__ void p0_expert_weights(Frame& F) {
    const Args& A = *F.a; unsigned char* ws = A.ws;
    LAS float* scr = (LAS float*)(F.lds + F.wave * 16640);
    const int gw = F.c * 8 + F.wave, NGW = F.G * 8;
    constexpr int NIT = NE * 512 + NE * 256;
    int it = gw; if (it >= NIT) return;
    f32x4 Ra[16], Rb[16]; XwItem da = xw_item(A, ws, it, F.lane), db = da;
    XW_LOAD(Ra, da);
    for (;;) {
        const int i1 = it + NGW; const bool h1 = i1 < NIT; if (h1) { db = xw_item(A, ws, i1, F.lane); XW_LOAD(Rb, db); }
        xw_finish(Ra, da, scr, F.lane);
        if (!h1) break;
        const int i2 = i1 + NGW; const bool h2 = i2 < NIT; if (h2) { da = xw_item(A, ws, i2, F.lane); XW_LOAD(Ra, da); }
        xw_finish(Rb, db, scr, F.lane);
        if (!h2) break;
        it = i2;
    }
}
#undef XW_LOAD

__device__ __forceinline__ void p0_prologue(Frame& F) {
    const Args& A = *F.a; unsigned char* ws = A.ws;
    LAS float* scr = (LAS float*)(F.lds + F.wave * 16640);
    const int gw = F.c * 8 + F.wave, NGW = F.G * 8;
    constexpr int I_IN = 16 * (IN_W / 64);
    constexpr int I_SQ = 16 * 16;
    constexpr int I_PP = 4 * 16;
    constexpr int NITEMS = I_IN + 4 * I_SQ + I_PP;
    p0_expert_weights(F);
    for (int it = gw; it < NITEMS; it += NGW) {
        int r = it;
        if (r < I_IN) { const int nb_ = r % (IN_W / 64);
            if (nb_ < 24 || nb_ >= 56) p0_transpose_item_f8(A.in[I_WIN], 1024, IN_W, ws + WS_WIN, A.in[I_GMIX], scr, r, F.lane, MapWinF8());
            else p0_transpose_item(A.in[I_WIN], 1024, IN_W, (bf16*)(ws + WS_WIN), A.in[I_GMIX], scr, r, F.lane, MapWinBf());
            continue; } r -= I_IN;
        if (r < I_SQ) { p0_transpose_item_f8(A.in[I_WABR], 1024, 1024, ws + WS_WABR, nullptr, scr, r, F.lane, MapId()); continue; } r -= I_SQ;
        if (r < I_SQ) { p0_transpose_item(A.in[I_WLBR], 1024, 1024, (bf16*)(ws + WS_WLBR), nullptr, scr, r, F.lane, MapId()); continue; } r -= I_SQ;
        if (r < I_SQ) { p0_transpose_item_f8(A.in[I_WOUT], 1024, 1024, ws + WS_WOUT, nullptr, scr, r, F.lane, MapId()); continue; } r -= I_SQ;
        if (r < I_SQ) { p0_transpose_item_f8(A.in[I_WPG], 1024, 1024, ws + WS_WPG, A.in[I_GPLE], scr, r, F.lane, MapId()); continue; } r -= I_SQ;
        p0_transpose_item(A.in[I_WPP], 256, 1024, (bf16*)(ws + WS_WPP), nullptr, scr, r, F.lane, MapId());
    }
    for (int it = gw; it < 2 * 32 * 2; it += NGW) { const int hl = it >> 6, ks = (it >> 1) & 31, nt = it & 1; const int e = 16 * nt + (F.lane & 15);
        unsigned w[4];
#pragma unroll
        for (int jj = 0; jj < 4; ++jj) { float v[2];
#pragma unroll
            for (int q = 0; q < 2; ++q) { const int k = 32 * ks + 8 * (F.lane >> 4) + 2 * jj + q; const float x = A.in[I_GMOE][k] * A.in[I_WR][k * NE + e]; const float h = bf2f((unsigned short)f2bf(x)); v[q] = hl ? (x - h) : x; }
            w[jj] = pk2(v[0], v[1]); }
        *(u32x4*)(ws + WS_RW + ((size_t)it * 64 + F.lane) * 16) = (u32x4){w[0], w[1], w[2], w[3]}; }
    {
        for (int m0 = gw; m0 < T; m0 += 2 * NGW) {
            const int m1 = m0 + NGW; const bool has1 = m1 < T;
            const f32x4* xr0 = (const f32x4*)(A.in[I_X] + (size_t)m0 * D_MODEL) + F.lane; const f32x4* xr1 = (const f32x4*)(A.in[I_X] + (size_t)(has1 ? m1 : m0) * D_MODEL) + F.lane;
            f32x4 v0[4], v1[4];
#pragma unroll
            for (int j = 0; j < 4; ++j) { v0[j] = xr0[64 * j]; v1[j] = xr1[64 * j]; }
            const f32x4 pv0 = *((const f32x4*)(A.in[I_P] + (size_t)m0 * PLE) + F.lane), pv1 = *((const f32x4*)(A.in[I_P] + (size_t)(has1 ? m1 : m0) * PLE) + F.lane);
            float s0 = 0.f, s1 = 0.f;
#pragma unroll
            for (int j = 0; j < 4; ++j) { s0 += (v0[j].x * v0[j].x + v0[j].y * v0[j].y) + (v0[j].z * v0[j].z + v0[j].w * v0[j].w); s1 += (v1[j].x * v1[j].x + v1[j].y * v1[j].y) + (v1[j].z * v1[j].z + v1[j].w * v1[j].w); }
            const float r0 = 1.0f / sqrtf(wave_sum(s0) * (1.f / D_MODEL) + EPS), r1 = 1.0f / sqrtf(wave_sum(s1) * (1.f / D_MODEL) + EPS);
            unsigned long long* o0 = (unsigned long long*)((bf16*)(ws + WS_U1) + (size_t)m0 * D_MODEL) + F.lane;
#pragma unroll
            for (int j = 0; j < 4; ++j) o0[64 * j] = (unsigned long long)cvt_pk_bf16(v0[j].x * r0, v0[j].y * r0) | ((unsigned long long)cvt_pk_bf16(v0[j].z * r0, v0[j].w * r0) << 32);
            { unsigned* q0 = (unsigned*)(ws + WS_H1F8 + (size_t)m0 * 1024) + F.lane;
#pragma unroll
              for (int j = 0; j < 4; ++j) { unsigned w8 = 0u; w8 = __builtin_amdgcn_cvt_pk_fp8_f32(v0[j].x * r0, v0[j].y * r0, w8, false); w8 = __builtin_amdgcn_cvt_pk_fp8_f32(v0[j].z * r0, v0[j].w * r0, w8, true); q0[64 * j] = w8; } }
            *((unsigned long long*)((bf16*)(ws + WS_PB) + (size_t)m0 * PLE) + F.lane) = (unsigned long long)cvt_pk_bf16(pv0.x, pv0.y) | ((unsigned long long)cvt_pk_bf16(pv0.z, pv0.w) << 32);
            if (has1) { unsigned long long* o1 = (unsigned long long*)((bf16*)(ws + WS_U1) + (size_t)m1 * D_MODEL) + F.lane;
#pragma unroll
                for (int j = 0; j < 4; ++j) o1[64 * j] = (unsigned long long)cvt_pk_bf16(v1[j].x * r1, v1[j].y * r1) | ((unsigned long long)cvt_pk_bf16(v1[j].z * r1, v1[j].w * r1) << 32);
                { unsigned* q1 = (unsigned*)(ws + WS_H1F8 + (size_t)m1 * 1024) + F.lane;
#pragma unroll
                  for (int j = 0; j < 4; ++j) { unsigned w8 = 0u; w8 = __builtin_amdgcn_cvt_pk_fp8_f32(v1[j].x * r1, v1[j].y * r1, w8, false); w8 = __builtin_amdgcn_cvt_pk_fp8_f32(v1[j].z * r1, v1[j].w * r1, w8, true); q1[64 * j] = w8; } }
                *((unsigned long long*)((bf16*)(ws + WS_PB) + (size_t)m1 * PLE) + F.lane) = (unsigned long long)cvt_pk_bf16(pv1.x, pv1.y) | ((unsigned long long)cvt_pk_bf16(pv1.z, pv1.w) << 32); }
        }
    }
}

__device__ __forceinline__ void p2_qknorm_rope(Frame& F) {
    const Args& A = *F.a; unsigned char* ws = A.ws;
    LAS float* tab = (LAS float*)F.lds;
    for (int i = F.tid; i < 64 * 32; i += 512) { const int id = i >> 5, j = i & 31; const float inv = powf(10000.0f, -(float)(2 * j) / 64.0f); float s, c; sincosf((float)id * inv, &s, &c); tab[2 * i] = c; tab[2 * i + 1] = s; }
    __syncthreads();
    const int sub = F.lane >> 3, li = F.lane & 7;
    const long nitems = (long)T * 2;
    const float* gn = A.in[I_KN];
    f32x4 gv[4];
#pragma unroll
    for (int q = 0; q < 4; ++q) gv[q] = *(const f32x4*)(gn + 32 * q + 4 * li);
    for (long it0 = ((long)F.c * 8 + F.wave) * 8; it0 < nitems; it0 += (long)F.G * 64 * 4) {
        u32x2 wv[4][4]; bool ok[4];
#pragma unroll
        for (int u = 0; u < 4; ++u) { const long it = it0 + (long)u * F.G * 64 + sub; ok[u] = it < nitems; const long itc = ok[u] ? it : (long)sub; const int tok = (int)(itc >> 1), kh = (int)(itc & 1);
            const bf16* p = (const bf16*)(ws + WS_K) + (size_t)tok * 256 + kh * 128;
#pragma unroll
            for (int q = 0; q < 4; ++q) wv[u][q] = *(const u32x2*)(p + 32 * q + 4 * li); }
#pragma unroll
        for (int u = 0; u < 4; ++u) { const long it = it0 + (long)u * F.G * 64 + sub; const int tok = (int)(it >> 1), kh = (int)(it & 1);
            bf16* p = (bf16*)(ws + WS_K) + (size_t)tok * 256 + kh * 128;
            float v[4][4]; float ss = 0.f;
#pragma unroll
            for (int q = 0; q < 4; ++q) { const u32x2 w = wv[u][q]; v[q][0] = bflo(w.x); v[q][1] = bfhi(w.x); v[q][2] = bflo(w.y); v[q][3] = bfhi(w.y);
                ss += (v[q][0] * v[q][0] + v[q][1] * v[q][1]) + (v[q][2] * v[q][2] + v[q][3] * v[q][3]); }
            ss += __shfl_xor(ss, 1); ss += __shfl_xor(ss, 2); ss += __shfl_xor(ss, 4);
            const float rstd = 1.0f / sqrtf(ss * (1.f / 128.f) + EPS);
#pragma unroll
            for (int q = 0; q < 4; ++q) {
#pragma unroll
                for (int e = 0; e < 4; ++e) v[q][e] = v[q][e] * rstd * gv[q][e]; }
            const int s = tok & (SEQ - 1), rid = s >> 6, cid = s & 63;
            float o[4][4];
#pragma unroll
            for (int e = 0; e < 4; ++e) { const int j = 4 * li + e;
                const float cr = tab[2 * (rid * 32 + j)], sr = tab[2 * (rid * 32 + j) + 1], cc = tab[2 * (cid * 32 + j)], sc = tab[2 * (cid * 32 + j) + 1];
                o[0][e] = v[0][e] * cr - v[1][e] * sr; o[1][e] = v[1][e] * cr + v[0][e] * sr;
                o[2][e] = v[2][e] * cc - v[3][e] * sc; o[3][e] = v[3][e] * cc + v[2][e] * sc; }
            if (ok[u]) {
#pragma unroll
                for (int q = 0; q < 4; ++q) { u32x2 w; w.x = pk2(o[q][0], o[q][1]); w.y = pk2(o[q][2], o[q][3]); *(u32x2*)(p + 32 * q + 4 * li) = w; } } }
    }
    __syncthreads();
}

__device__ __forceinline__ void p3_lru_unit(Frame& F, int unit) {
    const Args& A = *F.a; unsigned char* ws = A.ws;
    const int b = unit >> 4, nb = (unit >> 1) & 7, hb = unit & 1;
    LAS unsigned char* CA = F.lds; LAS float* CF = (LAS float*)(F.lds + 32768); LAS float* HT = (LAS float*)F.lds;
    LAS float* EX = (LAS float*)(F.lds + 65536); LAS float* CW = (LAS float*)(F.lds + 67584); LAS unsigned char* WB = F.lds + 70656;
    int tid_ = threadIdx.x; asm volatile("" : "+v"(tid_));
    const int tid = tid_, w = F.wave, lane = tid & 63, r32 = lane & 31, hi = lane >> 5;
    const int d = w >> 2, mt = (w >> 1) & 1, cb = w & 1;
    const int chl = 32 * cb + r32;
    const int chb = 64 * hb + chl;
    const int chg = nb * 128 + chb;
#define LBAR() do { asm volatile("s_waitcnt lgkmcnt(0)" ::: "memory"); __builtin_amdgcn_s_barrier(); asm volatile("" ::: "memory"); } while (0)
    { const int i1 = tid + 512; const bool h1_ = i1 < 5 * 128;
      const float c0 = A.in[I_CONVW][(tid >> 7) * LRU_W + nb * 128 + (tid & 127)];
      const float c1 = h1_ ? A.in[I_CONVB][nb * 128 + (i1 & 127)] : 0.f;
      CW[tid] = c0; if (h1_) CW[i1] = c1; }
    {
        f32x4 wv_[16];
#pragma unroll
        for (int it = 0; it < 16; ++it) { const int i = tid + it * 512; const int e4 = (i & 15) * 4, k = (i >> 4) & 127, gsel = (i >> 11) & 1, dd = i >> 12;
            wv_[it] = *(const f32x4*)((gsel ? A.in[I_LWI] : A.in[I_LWA]) + ((size_t)(dd * 8 + nb) * 128 + k) * 128 + 64 * hb + e4); }
#pragma unroll
        for (int it = 0; it < 16; ++it) { const int i = tid + it * 512; const int e4 = (i & 15) * 4, k = (i >> 4) & 127, gsel = (i >> 11) & 1, dd = i >> 12; const f32x4 v = wv_[it];
#pragma unroll
            for (int q = 0; q < 4; ++q) *(LAS unsigned short*)(WB + (dd * 2 + gsel) * 16384 + KSWZ(e4 + q, 2 * k)) = (unsigned short)f2bf(v[q]); } }
    const float nba = -1.4426950408889634f * A.in[I_LBA][d * LRU_W + chg], nbi = -1.4426950408889634f * A.in[I_LBI][d * LRU_W + chg];
    float k8; { const float lam = A.in[I_LAM][d * LRU_W + chg]; const float z = -lam; const float sp = (z > 20.f) ? z : log1pf(expf(z)); k8 = -8.0f * sp * 1.4426950408889634f; }
    float carry = 0.f;
    const bf16* XR = (const bf16*)(ws + WS_XR) + (size_t)b * SEQ * 1024 + nb * 128;
    bf16* XG = (bf16*)(ws + WS_XG) + (size_t)b * SEQ * 1024 + nb * 128 + hb * 64;
    bf16* HTMP = (bf16*)(ws + WS_U1) + (size_t)b * SEQ * 1024 + nb * 128 + hb * 64;
    const int sg = tid & 15, sr4 = (tid >> 4) & 15, sdd = tid >> 8;
    const int og = tid & 3, orow = (tid >> 2) & 63, odd = tid >> 8;
    u32x4 PF[7];
    const __amdgpu_buffer_rsrc_t xr_rsrc = __builtin_amdgcn_make_buffer_rsrc((void*)((const bf16*)(ws + WS_XR) + (size_t)b * SEQ * 1024), 0, SEQ * 2048, 0x00020000);
#define LRU_PF(jn) do { const int t0_ = 64 * (sdd ? 31 - (jn) : (jn)) + 4 * sr4 - 2; _Pragma("unroll") for (int i_ = 0; i_ < 7; ++i_) \
        PF[i_] = __builtin_bit_cast(u32x4, __builtin_amdgcn_raw_buffer_load_b128(xr_rsrc, (unsigned)((t0_ + i_) * 2048 + (nb * 128 + 8 * sg) * 2), 0, 0)); } while (0)
    LRU_PF(0);
    __syncthreads();
    for (int j = 0; j < 32; ++j) {
        { f32x2 wv[4][4], bvv[4];
#pragma unroll
          for (int k = 0; k < 4; ++k) { const f32x4 w0 = *(const LAS f32x4*)(CW + k * 128 + 8 * sg), w1 = *(const LAS f32x4*)(CW + k * 128 + 8 * sg + 4);
              wv[k][0] = (f32x2){w0[0], w0[1]}; wv[k][1] = (f32x2){w0[2], w0[3]}; wv[k][2] = (f32x2){w1[0], w1[1]}; wv[k][3] = (f32x2){w1[2], w1[3]}; }
          { const f32x4 b0 = *(const LAS f32x4*)(CW + 4 * 128 + 8 * sg), b1 = *(const LAS f32x4*)(CW + 4 * 128 + 8 * sg + 4);
            bvv[0] = (f32x2){b0[0], b0[1]}; bvv[1] = (f32x2){b0[2], b0[3]}; bvv[2] = (f32x2){b1[0], b1[1]}; bvv[3] = (f32x2){b1[2], b1[3]}; }
#pragma unroll
          for (int rr = 0; rr < 4; ++rr) { f32x2 c[4] = {bvv[0], bvv[1], bvv[2], bvv[3]};
#pragma unroll
            for (int k = 0; k < 4; ++k) { const u32x4 xv = PF[rr + k];
                c[0] = wv[k][0] * (f32x2){bflo(xv.x), bfhi(xv.x)} + c[0]; c[1] = wv[k][1] * (f32x2){bflo(xv.y), bfhi(xv.y)} + c[1];
                c[2] = wv[k][2] * (f32x2){bflo(xv.z), bfhi(xv.z)} + c[2]; c[3] = wv[k][3] * (f32x2){bflo(xv.w), bfhi(xv.w)} + c[3]; }
            const int r = 4 * sr4 + rr;
            u32x4 pw; pw.x = cvt_pk_bf16(c[0].x, c[0].y); pw.y = cvt_pk_bf16(c[1].x, c[1].y); pw.z = cvt_pk_bf16(c[2].x, c[2].y); pw.w = cvt_pk_bf16(c[3].x, c[3].y);
            *(LAS u32x4*)(CA + sdd * 16384 + KSWZ(r, 16 * sg)) = pw;
            if ((sg >> 3) == hb) { LAS float* cf = CF + (sdd * 64 + r) * 64 + 8 * (sg & 7); *(LAS f32x4*)cf = (f32x4){c[0].x, c[0].y, c[1].x, c[1].y}; *(LAS f32x4*)(cf + 4) = (f32x4){c[2].x, c[2].y, c[3].x, c[3].y}; } } }
        if (j + 1 < 32) LRU_PF(j + 1);
        LBAR();
        f32x16 ga = {}, gi = {};
#pragma unroll
        for (int ks = 0; ks < 8; ++ks) { const bf16x8 af = *(const LAS bf16x8*)(CA + d * 16384 + KSWZ(32 * mt + r32, (ks * 16 + hi * 8) * 2));
            const bf16x8 bfa = *(const LAS bf16x8*)(WB + (d * 2 + 0) * 16384 + KSWZ(chl, (ks * 16 + hi * 8) * 2)), bfi = *(const LAS bf16x8*)(WB + (d * 2 + 1) * 16384 + KSWZ(chl, (ks * 16 + hi * 8) * 2));
            ga = __builtin_amdgcn_mfma_f32_32x32x16_bf16(af, bfa, ga, 0, 0, 0); gi = __builtin_amdgcn_mfma_f32_32x32x16_bf16(af, bfi, gi, 0, 0, 0); }
        float av[16], bv[16];
#pragma unroll
        for (int r = 0; r < 16; ++r) { const int row = 32 * mt + attn::crow(r, hi);
            const float ra = __builtin_amdgcn_rcpf(1.0f + __builtin_amdgcn_exp2f(__builtin_fmaf(ga[r], -1.4426950408889634f, nba))), ii = __builtin_amdgcn_rcpf(1.0f + __builtin_amdgcn_exp2f(__builtin_fmaf(gi[r], -1.4426950408889634f, nbi)));
            const float a = __builtin_amdgcn_exp2f(k8 * ra); const float mult = __builtin_amdgcn_sqrtf(fmaxf(1.0f - a * a, 0.f));
            av[r] = a; bv[r] = mult * ii * CF[(d * 64 + row) * 64 + chl]; }
        float A4[4], H4[4];
#pragma unroll
        for (int q = 0; q < 4; ++q) { float hh = 0.f, aa = 1.f;
            if (d == 0) {
#pragma unroll
                for (int i = 0; i < 4; ++i) { hh = av[4 * q + i] * hh + bv[4 * q + i]; aa *= av[4 * q + i]; } }
            else {
#pragma unroll
                for (int i = 3; i >= 0; --i) { hh = av[4 * q + i] * hh + bv[4 * q + i]; aa *= av[4 * q + i]; } }
            A4[q] = aa; H4[q] = hh; }
        float Ag[8], Hg[8];
#pragma unroll
        for (int q = 0; q < 4; ++q) { auto ra = __builtin_amdgcn_permlane32_swap(__float_as_uint(A4[q]), __float_as_uint(A4[q]), false, false); auto rh = __builtin_amdgcn_permlane32_swap(__float_as_uint(H4[q]), __float_as_uint(H4[q]), false, false);
            Ag[2 * q] = __uint_as_float(ra[0]); Ag[2 * q + 1] = __uint_as_float(ra[1]); Hg[2 * q] = __uint_as_float(rh[0]); Hg[2 * q + 1] = __uint_as_float(rh[1]); }
        float Ac[4], Hc[4];
        float At = 1.f, Ht = 0.f;
        if (d == 0) {
#pragma unroll
            for (int g = 0; g < 8; ++g) { if ((g & 1) == hi) { Ac[g >> 1] = At; Hc[g >> 1] = Ht; } Ht = Ag[g] * Ht + Hg[g]; At = Ag[g] * At; } }
        else {
#pragma unroll
            for (int g = 7; g >= 0; --g) { if ((g & 1) == hi) { Ac[g >> 1] = At; Hc[g >> 1] = Ht; } Ht = Ag[g] * Ht + Hg[g]; At = Ag[g] * At; } }
        if (hi == 0) { LAS float* ex = EX + ((d * 2 + mt) * 64 + chl) * 2; ex[0] = At; ex[1] = Ht; }
        u32x4 oph0 = {0u, 0u, 0u, 0u}, oph1 = {0u, 0u, 0u, 0u}, opx0 = {0u, 0u, 0u, 0u}, opx1 = {0u, 0u, 0u, 0u};
        const size_t ooff = (size_t)(64 * (odd ? 31 - j : j) + orow) * 1024 + 16 * og;
        if (j >= 16) { oph0 = *(const u32x4*)(HTMP + ooff); oph1 = *(const u32x4*)(HTMP + ooff + 8); opx0 = *(const u32x4*)(XG + ooff); opx1 = *(const u32x4*)(XG + ooff + 8); }
        LBAR();
        { const LAS float* e0 = EX + ((d * 2 + 0) * 64 + chl) * 2; const LAS float* e1 = EX + ((d * 2 + 1) * 64 + chl) * 2;
          const float A0 = e0[0], H0 = e0[1], A1 = e1[0], H1 = e1[1]; float hin;
          if (d == 0) { const float h1in = A0 * carry + H0; hin = mt ? h1in : carry; carry = A1 * h1in + H1; }
          else { const float h0in = A1 * carry + H1; hin = mt ? carry : h0in; carry = A0 * h0in + H0; }
#pragma unroll
          for (int q = 0; q < 4; ++q) { float hh = Ac[q] * hin + Hc[q];
              if (d == 0) {
#pragma unroll
                  for (int i = 0; i < 4; ++i) { hh = av[4 * q + i] * hh + bv[4 * q + i]; HT[(d * 64 + 32 * mt + attn::crow(4 * q + i, hi)) * 64 + chl] = hh; } }
              else {
#pragma unroll
                  for (int i = 3; i >= 0; --i) { hh = av[4 * q + i] * hh + bv[4 * q + i]; HT[(d * 64 + 32 * mt + attn::crow(4 * q + i, hi)) * 64 + chl] = hh; } } } }
        LBAR();
        { const LAS float* hp = HT + (odd * 64 + orow) * 64 + 16 * og; const f32x4 h0 = *(const LAS f32x4*)hp, h1 = *(const LAS f32x4*)(hp + 4), h2 = *(const LAS f32x4*)(hp + 8), h3 = *(const LAS f32x4*)(hp + 12);
          if (j < 16) { u32x4 o0, o1; o0.x = cvt_pk_bf16(h0[0], h0[1]); o0.y = cvt_pk_bf16(h0[2], h0[3]); o0.z = cvt_pk_bf16(h1[0], h1[1]); o0.w = cvt_pk_bf16(h1[2], h1[3]); o1.x = cvt_pk_bf16(h2[0], h2[1]); o1.y = cvt_pk_bf16(h2[2], h2[3]); o1.z = cvt_pk_bf16(h3[0], h3[1]); o1.w = cvt_pk_bf16(h3[2], h3[3]);
              *(u32x4*)(HTMP + ooff) = o0; *(u32x4*)(HTMP + ooff + 8) = o1; }
          else { u32x4 o0, o1;
#define LRU_R2(hv, i0, oh, ox) cvt_pk_bf16((hv[i0] + bflo(oh)) * bflo(ox), (hv[i0 + 1] + bfhi(oh)) * bfhi(ox))
              o0.x = LRU_R2(h0, 0, oph0.x, opx0.x); o0.y = LRU_R2(h0, 2, oph0.y, opx0.y); o0.z = LRU_R2(h1, 0, oph0.z, opx0.z); o0.w = LRU_R2(h1, 2, oph0.w, opx0.w);
              o1.x = LRU_R2(h2, 0, oph1.x, opx1.x); o1.y = LRU_R2(h2, 2, oph1.y, opx1.y); o1.z = LRU_R2(h3, 0, oph1.z, opx1.z); o1.w = LRU_R2(h3, 2, oph1.w, opx1.w);
#undef LRU_R2
              *(u32x4*)(XG + ooff) = o0; *(u32x4*)(XG + ooff + 8) = o1; } }
        if (j == 15) { VM_WAIT(); }
        LBAR();
    }
#undef LRU_PF
#undef LBAR
}

__device__ __forceinline__ void p6_router(Frame& F) {
    const Args& A = *F.a; unsigned char* ws = A.ws;
    LAS float* LG = (LAS float*)F.lds;
    LAS int* LC = (LAS int*)(F.lds + 32768);
    LAS int* LB = (LAS int*)(F.lds + 32768 + 256);
    const bf16* H1 = (const bf16*)(ws + WS_H1);
    const int lane = F.lane, w = F.wave, l15 = lane & 15, l4 = lane >> 4;
    for (int grp = F.c; grp < T / 128; grp += F.G) {
        if (F.tid < 32) LC[F.tid] = 0;
        __syncthreads();
        const int tb = grp * 128 + w * 16;
        const bf16* hrow = H1 + (size_t)(tb + l15) * 1024 + 8 * l4;
        f32x4 acc0 = {0.f, 0.f, 0.f, 0.f}, acc1 = {0.f, 0.f, 0.f, 0.f}; float ss = 0.f;
        unsigned char* u8 = ws + WS_H1F8 + (size_t)(tb + l15) * 1024 + 8 * l4;
#pragma unroll 1
        for (int kc = 0; kc < 32; kc += 8) {
            u32x4 xa[8];
#pragma unroll
            for (int q = 0; q < 8; ++q) xa[q] = *(const u32x4*)(hrow + 32 * (kc + q));
#pragma unroll
            for (int q = 0; q < 8; ++q) { const int ks = kc + q; const u32x4 hx = xa[q];
            const float x0 = bflo(hx.x), x1 = bfhi(hx.x), x2 = bflo(hx.y), x3 = bfhi(hx.y), x4 = bflo(hx.z), x5 = bfhi(hx.z), x6 = bflo(hx.w), x7 = bfhi(hx.w);
            { u32x2 w8 = {0u, 0u};
              w8.x = __builtin_amdgcn_cvt_pk_fp8_f32(x0, x1, w8.x, false); w8.x = __builtin_amdgcn_cvt_pk_fp8_f32(x2, x3, w8.x, true);
              w8.y = __builtin_amdgcn_cvt_pk_fp8_f32(x4, x5, w8.y, false); w8.y = __builtin_amdgcn_cvt_pk_fp8_f32(x6, x7, w8.y, true);
              *(u32x2*)(u8 + 32 * ks) = w8; }
            ss = __builtin_fmaf(x0, x0, ss); ss = __builtin_fmaf(x1, x1, ss); ss = __builtin_fmaf(x2, x2, ss); ss = __builtin_fmaf(x3, x3, ss);
            ss = __builtin_fmaf(x4, x4, ss); ss = __builtin_fmaf(x5, x5, ss); ss = __builtin_fmaf(x6, x6, ss); ss = __builtin_fmaf(x7, x7, ss);
            u32x4 uh = hx; const bf16x8 ah = *reinterpret_cast<bf16x8*>(&uh);
            const unsigned char* rw = ws + WS_RW + ((size_t)(ks * 2) * 64 + lane) * 16;
            const bf16x8 bh0 = *(const bf16x8*)(rw), bh1 = *(const bf16x8*)(rw + 1024), bl0 = *(const bf16x8*)(rw + 65536), bl1 = *(const bf16x8*)(rw + 65536 + 1024);
            acc0 = __builtin_amdgcn_mfma_f32_16x16x32_bf16(ah, bh0, acc0, 0, 0, 0); acc0 = __builtin_amdgcn_mfma_f32_16x16x32_bf16(ah, bl0, acc0, 0, 0, 0);
            acc1 = __builtin_amdgcn_mfma_f32_16x16x32_bf16(ah, bh1, acc1, 0, 0, 0); acc1 = __builtin_amdgcn_mfma_f32_16x16x32_bf16(ah, bl1, acc1, 0, 0, 0); } }
        ss += __shfl_xor(ss, 16); ss += __shfl_xor(ss, 32);
        const float rstd = 1.0f / sqrtf(ss * (1.f / 1024.f) + EPS);
        if (l4 == 0) ((float*)(ws + WS_RSTD1))[tb + l15] = rstd;
        LAS float* lg = LG + w * (16 * 33);
#pragma unroll
        for (int r = 0; r < 4; ++r) { lg[(4 * l4 + r) * 33 + l15] = acc0[r]; lg[(4 * l4 + r) * 33 + 16 + l15] = acc1[r]; }
        if (l4 == 0) lg[l15 * 33 + 32] = rstd;
        LDS_WAIT(); asm volatile("" ::: "memory");
        int ek[4] = {0, 0, 0, 0}, lp[4] = {0, 0, 0, 0}; float gk[4] = {0.f, 0.f, 0.f, 0.f};
        if (lane < 16) { float v[32]; const float rsd = lg[lane * 33 + 32];
#pragma unroll
            for (int e = 0; e < 32; ++e) v[e] = lg[lane * 33 + e] * rsd + A.in[I_BR][e];
            float tv[4];
#pragma unroll
            for (int k = 0; k < 4; ++k) { float best = -3.0e38f; int bi_ = 0;
#pragma unroll
                for (int e = 0; e < 32; ++e) { const bool gt = v[e] > best; best = gt ? v[e] : best; bi_ = gt ? e : bi_; }
                tv[k] = best; ek[k] = bi_;
#pragma unroll
                for (int e = 0; e < 32; ++e) v[e] = (e == bi_) ? -3.0e38f : v[e]; }
            float es[4], sum = 0.f;
#pragma unroll
            for (int k = 0; k < 4; ++k) { es[k] = __expf(tv[k] - tv[0]); sum += es[k]; }
            const float inv = 1.0f / sum;
#pragma unroll
            for (int k = 0; k < 4; ++k) { gk[k] = es[k] * inv; lp[k] = __hip_atomic_fetch_add(&LC[ek[k]], 1, __ATOMIC_RELAXED, __HIP_MEMORY_SCOPE_WORKGROUP); } }
        __syncthreads();
        if (F.tid < 32) LB[F.tid] = (int)__hip_atomic_fetch_add((unsigned*)(ws + WS_CTL) + CW_CNT + F.tid, (unsigned)LC[F.tid], RLX_AGENT);
        __syncthreads();
        if (lane < 16) { const int tok = tb + lane;
#pragma unroll
            for (int k = 0; k < 4; ++k) { const int pos = LB[ek[k]] + lp[k]; ((int*)(ws + WS_LIST))[(size_t)ek[k] * LIST_CAP + pos] = tok * 4 + k; ((float*)(ws + WS_GATES))[tok * 4 + k] = gk[k]; } }
        __syncthreads();
    }
}

__device__ __forceinline__ int moe_tables(Frame& F, LAS int* TAB) {
    unsigned* cnt = (unsigned*)(F.a->ws + WS_CTL) + CW_CNT;
    __syncthreads();
    if (F.tid < 64) {
        const int e = F.lane; const int c = (e < NE) ? (int)__hip_atomic_load(cnt + (e & (NE - 1)), RLX_AGENT) : 0; const int nt = (c + 255) >> 8;
        int pre = nt;
#pragma unroll
        for (int o = 1; o < 32; o <<= 1) { const int v = __shfl_up(pre, o); if (e >= o) pre += v; }
        const int start = pre - nt;
        if (e < NE) { TAB[1 + e] = start; TAB[33 + e] = c; for (int i = 0; i < nt; ++i) TAB[96 + start + i] = e; }
        if (e == NE - 1) TAB[0] = pre; }
    __syncthreads();
    return __builtin_amdgcn_readfirstlane(TAB[0]);
}

template <class Sched>
__device__ __forceinline__ void moe_prepare(Frame& F, const Sched& S, LAS int* TAB, LAS int* GMAP) {
    const Args& A = *F.a; unsigned char* ws = A.ws;
    const int* list = (const int*)(ws + WS_LIST); const float* gates = (const float*)(ws + WS_GATES);
    u32x2* smeta = (u32x2*)(ws + WS_STOK);
    LAS int* UPM = TAB + 700;
    int nu = 0;
    if (F.tid == 0) { pg8::Unit u; int i = 0; for (; i < 20 && S.next(i, u); ++i) UPM[i] = u.pm; UPM[20] = i; }
    __syncthreads();
    nu = __builtin_amdgcn_readfirstlane(UPM[20]);
    constexpr int NIT = 10;
    int ent[NIT]; int slot[NIT];
#pragma unroll
    for (int k = 0; k < NIT; ++k) { const int item = k * 512 + F.tid, ui = item >> 8, r = item & 255; ent[k] = -2; slot[k] = 0;
        if (ui < nu) { const int pm = UPM[ui], e = TAB[96 + pm], idx = (pm - TAB[1 + e]) * 256 + r; slot[k] = pm * 256 + r; ent[k] = (idx < TAB[33 + e]) ? list[(size_t)e * LIST_CAP + idx] : -1; } }
    float gt[NIT], rs_[NIT]; const float* rstd1 = (const float*)(ws + WS_RSTD1); float* srs = (float*)(ws + WS_SGATE);
#pragma unroll
    for (int k = 0; k < NIT; ++k) { gt[k] = 0.f; rs_[k] = 1.f; if (ent[k] >= 0) { gt[k] = gates[ent[k]]; rs_[k] = rstd1[ent[k] >> 2]; } }
#pragma unroll
    for (int k = 0; k < NIT; ++k) if (ent[k] > -2) { const int item = k * 512 + F.tid; GMAP[item] = ent[k] >= 0 ? (ent[k] >> 2) : 0; smeta[slot[k]] = (u32x2){(unsigned)ent[k], __float_as_uint(gt[k])}; srs[slot[k]] = rs_[k]; }
    VM_WAIT();
    __syncthreads();
}

__device__ __forceinline__ void p10_combine(Frame& F) {
    const Args& A = *F.a; unsigned char* ws = A.ws;
    const bf16* H1 = (const bf16*)(ws + WS_H1); const unsigned char* Y = ws + WS_YK; unsigned char* H2B = ws + WS_H1B; bf16* H2H = (bf16*)(ws + WS_H2H); float* rstd2 = (float*)(ws + WS_RSTD2);
    for (int m0 = F.c * 8 + F.wave; m0 < T; m0 += F.G * 16) {
        const int m1 = m0 + F.G * 8; const bool has1 = m1 < T;
        u32x2 hw[2][4]; unsigned yv[2][4][4];
#pragma unroll
        for (int r = 0; r < 2; ++r) { const int m = r ? (has1 ? m1 : m0) : m0;
#pragma unroll
            for (int j = 0; j < 4; ++j) { const int col = 256 * j + 4 * F.lane; hw[r][j] = *(const u32x2*)(H1 + (size_t)m * 1024 + col);
#pragma unroll
                for (int k = 0; k < 4; ++k) yv[r][j][k] = (k < NOMOE_K) ? *(const unsigned*)(Y + ((size_t)m * 4 + k) * 1024 + col) : 0u; } }
#pragma unroll
        for (int r = 0; r < 2; ++r) { const int m = r ? m1 : m0; if (r && !has1) break;
            float ss = 0.f;
#pragma unroll
            for (int j = 0; j < 4; ++j) { const int col = 256 * j + 4 * F.lane; const u32x2 hw_ = hw[r][j]; f32x4 h = {bflo(hw_.x), bfhi(hw_.x), bflo(hw_.y), bfhi(hw_.y)};
#pragma unroll
                for (int k = 0; k < NOMOE_K; ++k) { const unsigned y = yv[r][j][k];
                    const f32x2 lo = __builtin_amdgcn_cvt_pk_f32_fp8(y, false), hi2 = __builtin_amdgcn_cvt_pk_f32_fp8(y, true);
                    h[0] += lo[0] * 0.0625f; h[1] += lo[1] * 0.0625f; h[2] += hi2[0] * 0.0625f; h[3] += hi2[1] * 0.0625f; }
                ss += (h[0] * h[0] + h[1] * h[1]) + (h[2] * h[2] + h[3] * h[3]);
                u32x2 hb; hb.x = cvt_pk_bf16(h[0], h[1]); hb.y = cvt_pk_bf16(h[2], h[3]); *(u32x2*)(H2H + (size_t)m * 1024 + col) = hb; unsigned wv = 0u; wv = __builtin_amdgcn_cvt_pk_fp8_f32(h[0], h[1], wv, false); wv = __builtin_amdgcn_cvt_pk_fp8_f32(h[2], h[3], wv, true); *(unsigned*)(H2B + (size_t)m * 1024 + col) = wv; }
            ss = wave_sum(ss);
            if (F.lane == 0) rstd2[m] = 1.0f / sqrtf(ss * (1.f / 1024.f) + EPS); }
    }
}

constexpr int NPHASE = 11;
__global__ void __launch_bounds__(512, 2) mk_fwd(Args args) {
    extern __shared__ __attribute__((aligned(16))) unsigned char lds[];
    Frame F; F.lds = (LAS unsigned char*)lds; F.lds_g = (char*)lds; F.tid = threadIdx.x; F.lane = F.tid & 63; F.wave = __builtin_amdgcn_readfirstlane(F.tid >> 6); F.G = gridDim.x; F.c = blockIdx.x; F.a = &args;
    unsigned char* ws = args.ws;
    volatile LAS unsigned* LCTL = (volatile LAS unsigned*)(F.lds + LDS_CTL_OFF);
    if (F.tid < 64) LCTL[F.tid] = 0u;
    __syncthreads();
    XcdBarrier bar; bar.bar = (unsigned*)(ws + WS_CTL) + CW_BAR; bar.x = 0; bar.st = nullptr;
    if (args.use_bar) bar = xcd_barrier_post((unsigned*)(ws + WS_CTL) + CW_BAR, LCTL);
    const int lo = args.ph_lo, hi = args.ph_hi;
#ifdef PHASE_MASK
#define IN(k) (((PHASE_MASK >> (k)) & 1) && lo <= (k) && (k) < hi)
#else
#define IN(k) (lo <= (k) && (k) < hi)
#endif
#ifdef STAMP_SEL
#define STAMP(k) do { if (blockIdx.x == 0 && F.tid == 0) { const unsigned long long t_ = __builtin_amdgcn_s_memrealtime(); LCTL[16 + 2 * (k)] = (unsigned)t_; LCTL[17 + 2 * (k)] = (unsigned)(t_ >> 32); } } while (0)
#else
#define STAMP(k) do { } while (0)
#endif
#define SEAM(k) do { if (IN(k) && IN((k) + 1)) xcd_barrier(bar); STAMP((k) + 1); } while (0)
    LAS int* TAB = (LAS int*)(F.lds + LDS_TAB_OFF);

    STAMP(0);
    if (IN(0)) { p0_prologue(F); } SEAM(0);

    if (IN(1)) {
        { pg8::Gemm g{ws + WS_H1F8, ws + WS_WIN, T, 3584, 1024, 1024}; pg8::StaticOrder S; S.init(g, F.G, F.c);
          pg8::EpiInProj E{(bf16*)(ws + WS_Q), (bf16*)(ws + WS_K), (bf16*)(ws + WS_V), (bf16*)(ws + WS_XR), (bf16*)(ws + WS_XG), (bf16*)(ws + WS_GA), (bf16*)(ws + WS_GR), 0};
          pg8::gemm_phase<pg8::EpiInProj, pg8::StaticOrder, true, true>(F.lds, g, S, E); }
        { pg8::Gemm g{(const bf16*)(ws + WS_U1), (const bf16*)(ws + WS_WIN) + (size_t)3584 * 1024, T, 2048, 1024, 2048}; pg8::StaticOrder S; S.init(g, F.G, F.c);
          pg8::EpiInProj E{(bf16*)(ws + WS_Q), (bf16*)(ws + WS_K), (bf16*)(ws + WS_V), (bf16*)(ws + WS_XR), (bf16*)(ws + WS_XG), (bf16*)(ws + WS_GA), (bf16*)(ws + WS_GR), 6};
          pg8::gemm_phase<pg8::EpiInProj, pg8::StaticOrder>(F.lds, g, S, E); }
        { pg8::Gemm g{(const bf16*)(ws + WS_PB), (const bf16*)(ws + WS_WPP), T, 1024, PLE, 2 * PLE}; pg8::StaticOrder S; S.init(g, F.G, F.c);
          pg8::EpiF8x8 E{ws + WS_PP, 1024};
          pg8::gemm_phase<pg8::EpiF8x8, pg8::StaticOrder>(F.lds, g, S, E); }
    } SEAM(1);

    if (IN(2)) { p2_qknorm_rope(F); } SEAM(2);

    if (IN(3)) {
        attn::build_rope_table((float*)(F.lds_g + 98304), F.tid);
        __syncthreads();
        for (int L = F.c; L < BATCH * NQH * (SEQ / 256); L += F.G) {
            const int grp = (L >> 8) * 8 + (L & 7), jj = (L & 255) >> 3;
            const int b = grp >> 1, kvh = grp & 1, h = kvh * 4 + (jj & 3), qb = jj >> 2;
            bf16* Qb = (bf16*)(ws + WS_Q) + ((size_t)b * SEQ + qb * 256) * 1024 + h * 128;
            const bf16* Kh = (const bf16*)(ws + WS_K) + (size_t)b * SEQ * 256 + kvh * 128; const bf16* Vh = (const bf16*)(ws + WS_V) + (size_t)b * SEQ * 256 + kvh * 128;
            attn::attn_dense_body(Qb, Kh, Vh, ws + WS_O8 + ((size_t)b * SEQ + qb * 256) * 1024 + h * 128, SEQ, F.lds_g, args.in[I_QN], (const float*)(F.lds_g + 98304), qb * 256);
        }
        STAMP(13);
        for (int u = F.c; u < 256; u += F.G) p3_lru_unit(F, u);
    } SEAM(3);

    if (IN(4)) {
        { pg8::Gemm g{ws + WS_O8, ws + WS_WABR, T, 1024, 1024, 1024}; pg8::StaticOrder S; S.init(g, F.G, F.c);
          pg8::EpiGate<0, true> E{(const bf16*)(ws + WS_GA), nullptr, (bf16*)(ws + WS_U1)};
          pg8::gemm_phase<pg8::EpiGate<0, true>, pg8::StaticOrder, true, true>(F.lds, g, S, E); }
        VM_WAIT(); __syncthreads();
        { pg8::Gemm g{(const bf16*)(ws + WS_XG), (const bf16*)(ws + WS_WLBR), T, 1024, 1024, 2048}; pg8::StaticOrder S; S.init(g, F.G, F.c);
          pg8::EpiGate<1, true, true> E{(const bf16*)(ws + WS_GR), (const bf16*)(ws + WS_U1), (bf16*)(ws + WS_MRG)};
          pg8::gemm_phase<pg8::EpiGate<1, true, true>, pg8::StaticOrder>(F.lds, g, S, E); }
    } SEAM(4);

    if (IN(5)) {
        pg8::Gemm g{ws + WS_MRG, ws + WS_WOUT, T, 1024, 1024, 1024}; pg8::StaticOrder S; S.init(g, F.G, F.c);
        pg8::EpiResid E{args.in[I_X], (bf16*)(ws + WS_H1)};
        pg8::gemm_phase<pg8::EpiResid, pg8::StaticOrder, true, true>(F.lds, g, S, E);
    } SEAM(5);

    if (IN(6)) { p6_router(F); } SEAM(6);

    if (IN(7)) {
        const int ntile = moe_tables(F, TAB);
        pg8::Gemm g{ws + WS_H1F8, ws + WS_WGU, CAP, 2048, 1024, 1024}; pg8::MoeGatherOrder S; S.init_moe(g, ntile, F.G, F.c, TAB + 96, (size_t)2048 * 1024); S.gmap = (LAS int*)(F.lds + LDS_GMAP_OFF);
        moe_prepare(F, S, TAB, (LAS int*)(F.lds + LDS_GMAP_OFF));
        pg8::EpiSwiglu E{TAB + 96, args.in[I_BGU], ws + WS_ACT, (const float*)(ws + WS_SGATE)};
        pg8::gemm_phase<pg8::EpiSwiglu, pg8::MoeGatherOrder, true, true>(F.lds, g, S, E);
    } SEAM(7);

    if (IN(8)) {
        const int ntile = moe_tables(F, TAB);
        pg8::Gemm g{ws + WS_ACT, ws + WS_WDN, CAP, 1024, 1024, 1024}; pg8::MoeOrder S; S.init_moe(g, ntile, F.G, F.c, TAB + 96, (size_t)1024 * 1024);
        pg8::EpiDown E{TAB + 96, args.in[I_BDN], (const u32x2*)(ws + WS_STOK), ws + WS_YK};
        pg8::gemm_phase<pg8::EpiDown, pg8::MoeOrder, true, true>(F.lds, g, S, E);
    } SEAM(8);

    if (IN(9)) { p10_combine(F); } SEAM(9);

    if (IN(10)) {
        pg8::Gemm g{ws + WS_H1B, ws + WS_WPG, T, 1024, 1024, 1024}; pg8::StaticOrder S; S.init(g, F.G, F.c);
        pg8::EpiPle E{args.out, (const float*)(ws + WS_RSTD2), ws + WS_PP, (const bf16*)(ws + WS_H2H)};
        pg8::gemm_phase<pg8::EpiPle, pg8::StaticOrder, true, true>(F.lds, g, S, E);
    }
#ifdef STAMP_SEL
    xcd_barrier(bar); STAMP(11);
    if (blockIdx.x == 0 && F.tid == 0) {
        const unsigned long long t0 = ((unsigned long long)LCTL[17 + 2 * (STAMP_SEL)] << 32) | LCTL[16 + 2 * (STAMP_SEL)], t1 = ((unsigned long long)LCTL[17 + 2 * (STAMP_SEL2)] << 32) | LCTL[16 + 2 * (STAMP_SEL2)];
        args.out[0] += (float)(t1 - t0) * (0.01f / STAMP_DIV); }
#endif
#undef IN
#undef SEAM
}

extern "C" void kernel_launch(void* const* d_in, const int* in_sizes, int n_in, void* d_out, int out_size, void* d_ws, size_t ws_size, hipStream_t stream) {
    static int grid = 0;
    if (grid == 0) {
        if (n_in != 26 || out_size != T * D_MODEL || ws_size < WS_END) { fprintf(stderr, "kernel_launch: unexpected shapes (n_in %d out %d ws %zu, need ws >= %zu)\n", n_in, out_size, ws_size, (size_t)WS_END); grid = -1; return; }
        int dev = 0, cus = 0, per_cu = 0;
        if (hipGetDevice(&dev) != hipSuccess || hipDeviceGetAttribute(&cus, hipDeviceAttributeMultiprocessorCount, dev) != hipSuccess) { grid = -1; return; }
        if (hipFuncSetAttribute((const void*)mk_fwd, hipFuncAttributeMaxDynamicSharedMemorySize, LDS_BYTES) != hipSuccess) { fprintf(stderr, "kernel_launch: hipFuncSetAttribute failed\n"); grid = -1; return; }
        if (hipOccupancyMaxActiveBlocksPerMultiprocessor(&per_cu, (const void*)mk_fwd, 512, LDS_BYTES) != hipSuccess || per_cu < 1) { fprintf(stderr, "kernel_launch: occupancy query reports %d\n", per_cu); per_cu = 1; }
        (void)hipGetLastError();
        grid = cus;
    }
    if (grid < 0) return;
    (void)hipMemsetAsync((char*)d_ws + WS_CTL, 0, CTL_ZERO_BYTES, stream);
    Args a{};
    for (int i = 0; i < 26; ++i) a.in[i] = (const float*)d_in[i];
    a.out = (float*)d_out; a.ws = (unsigned char*)d_ws; a.pad = 0;
#if MK_N_LAUNCHES == 1
    a.ph_lo = 0; a.ph_hi = NPHASE; a.use_bar = 1;
    hipLaunchKernelGGL(mk_fwd, dim3(grid), dim3(512), LDS_BYTES, stream, a);
#else
    for (int p = 0; p < NPHASE; ++p) { a.ph_lo = p; a.ph_hi = p + 1; a.use_bar = 0; hipLaunchKernelGGL(mk_fwd, dim3(grid), dim3(512), LDS_BYTES, stream, a); }
#endif
}
```

```cpp
#ifdef NOMOE
#define NOMOE_K 0
#define PHASE_MASK 0x67F
#else
#define NOMOE_K 4
#endif
#include <hip/hip_runtime.h>
#include <cstdio>
#include <cstdint>
#include <cmath>

#ifndef MK_N_LAUNCHES
#define MK_N_LAUNCHES 1
#endif

#define GAS __attribute__((address_space(1)))
#define LAS __attribute__((address_space(3)))
typedef unsigned short bf16;
typedef unsigned short bf16_t;
typedef short bf16x8 __attribute__((ext_vector_type(8)));
typedef short s16x4 __attribute__((ext_vector_type(4)));
typedef float f32x4 __attribute__((ext_vector_type(4)));
typedef float f32x2 __attribute__((ext_vector_type(2)));
typedef float f32x16 __attribute__((ext_vector_type(16)));
typedef unsigned u32x4 __attribute__((ext_vector_type(4)));
typedef unsigned u32x2 __attribute__((ext_vector_type(2)));
typedef GAS unsigned gu32;

constexpr int D_MODEL = 1024, BATCH = 16, SEQ = 2048, T = BATCH * SEQ;
constexpr int NQH = 8, NKVH = 2, HD = 128, QW = NQH * HD, KVW = NKVH * HD;
constexpr int LRU_W = 1024, LRU_NB = 8, LRU_BD = 128;
constexpr int NE = 32, TOPK = 4, DEXP = 1024, PLE = 256;
constexpr int IN_W = QW + 2 * KVW + 2 * LRU_W + 2 * D_MODEL;
constexpr float EPS = 1e-6f;
constexpr int TK = T * TOPK;
constexpr int CAP = TK + NE * 256;
constexpr int LIST_CAP = T;

constexpr size_t MiB = 1u << 20;
constexpr size_t WS_CTL = 0, CTL_ZERO_BYTES = 64 * 1024;
constexpr size_t WS_RSTD1 = 512 * 1024;
constexpr size_t WS_RSTD2 = WS_RSTD1 + 128 * 1024;
constexpr size_t WS_RW = WS_RSTD2 + 128 * 1024;
constexpr size_t WS_LIST = 1 * MiB;
constexpr size_t WS_GATES = 5 * MiB;
constexpr size_t WS_STOK = WS_GATES + 512 * 1024;
constexpr size_t WS_SSCALE = WS_STOK + 640 * 1024;
constexpr size_t WS_SGATE = WS_SSCALE + 640 * 1024;
constexpr size_t WS_WIN = 8 * MiB;
constexpr size_t WS_WGU = 19 * MiB;
constexpr size_t WS_WDN = 147 * MiB;
constexpr size_t WS_H1F8 = 83 * MiB;
constexpr size_t WS_WABR = 211 * MiB, WS_WLBR = 213 * MiB, WS_WOUT = 215 * MiB, WS_WPG = 217 * MiB, WS_WPP = 219 * MiB;
constexpr size_t WS_PP = 221 * MiB;
constexpr size_t WS_EPOS = 445 * MiB;
constexpr size_t WS_O8 = WS_PP + 32 * MiB;
constexpr size_t WS_H1 = 285 * MiB;
constexpr size_t WS_H1B = 413 * MiB;
constexpr size_t WS_H2H = 869 * MiB;
constexpr size_t WS_S = 477 * MiB;
constexpr size_t WS_Q = WS_S;
constexpr size_t WS_K = WS_Q + 64 * MiB;
constexpr size_t WS_V = WS_K + 16 * MiB;
constexpr size_t WS_XR = WS_V + 16 * MiB;
constexpr size_t WS_XG = WS_XR + 64 * MiB;
constexpr size_t WS_GA = WS_XG + 64 * MiB;
constexpr size_t WS_GR = WS_GA + 64 * MiB;
constexpr size_t WS_U1 = WS_GR + 64 * MiB;
constexpr size_t WS_PB = WS_U1 + 64 * MiB;
constexpr size_t WS_MRG = WS_PB + 16 * MiB;
constexpr size_t WS_S_END1 = WS_MRG + 64 * MiB;
constexpr size_t WS_YK = WS_S;
constexpr size_t WS_ACT = WS_S + 256 * MiB;
constexpr size_t WS_END = 973 * MiB;
static_assert(WS_S_END1 <= 1024 * MiB && WS_END <= 1024 * MiB, "workspace map must fit 1 GiB");
static_assert(WS_SGATE + 640 * 1024 <= WS_WIN && (size_t)CAP * 4 <= 640 * 1024, "meta region");
constexpr int CW_CNT = 64;
constexpr int CW_BAR = 1024;

constexpr int LDS_BYTES = 163840;
constexpr int LDS_GMAP_OFF = 131072;
constexpr int LDS_TAB_OFF = 151552;
constexpr int LDS_CTL_OFF = 155648;

__device__ __forceinline__ unsigned f2bf(float f) { unsigned u = __builtin_bit_cast(unsigned, f); return (u + 0x7fffu + ((u >> 16) & 1u)) >> 16; }
__device__ __forceinline__ unsigned pk2(float lo, float hi) { return f2bf(lo) | (f2bf(hi) << 16); }
__device__ __forceinline__ float bf2f(unsigned short h) { return __builtin_bit_cast(float, (unsigned)h << 16); }
__device__ __forceinline__ float bflo(unsigned w) { return __builtin_bit_cast(float, w << 16); }
__device__ __forceinline__ float bfhi(unsigned w) { return __builtin_bit_cast(float, w & 0xffff0000u); }
__device__ __forceinline__ unsigned cvt_pk_bf16(float lo, float hi) { unsigned r; asm volatile("v_cvt_pk_bf16_f32 %0, %1, %2" : "=v"(r) : "v"(lo), "v"(hi)); return r; }
__device__ __forceinline__ float sigmoidf_(float x) { return __builtin_amdgcn_rcpf(1.0f + __builtin_amdgcn_exp2f(-1.4426950408889634f * x)); }
__device__ __forceinline__ float gelu_tanh_(float x) { const float u = 1.5957691216057308f * (x + 0.044715f * x * x * x); return x * sigmoidf_(u); }
__device__ __forceinline__ float wave_sum(float v) {
#pragma unroll
    for (int o = 1; o < 64; o <<= 1) v += __shfl_xor(v, o);
    return v;
}
#define LDS_WAIT() asm volatile("s_waitcnt lgkmcnt(0)" ::: "memory")
#define VM_WAIT() asm volatile("s_waitcnt vmcnt(0)" ::: "memory")
#define RLX_AGENT __ATOMIC_RELAXED, __HIP_MEMORY_SCOPE_AGENT

namespace pg8 {
#define PG8_LAS __attribute__((address_space(3)))
constexpr int BM = 256, BK = 64, HALF = 128, HTB = HALF * BK * 2, STAGE_BYTES = 8 * HTB, NXCD = 8, WGM = 8;
typedef int v4i_t __attribute__((ext_vector_type(4)));
typedef int v8i_t __attribute__((ext_vector_type(8)));
#ifdef F8_PLAIN
constexpr float F8_ACC_SCALE = 1.0f / 32.0f;
#else
constexpr float F8_ACC_SCALE = 1.0f;
#endif
constexpr int F8_SCALE_W = 0x7A7A7A7A, F8_SCALE_A = 0x7F7F7F7F;
__host__ __device__ __forceinline__ int lds_byte(int r, int c) { const int st = (r >> 4) * 2 + (c >> 5), rr = r & 15, cc = c & 31, ob = rr * 64 + cc * 2; return st * 1024 + (ob ^ (((ob >> 9) & 1) << 5)); }
__host__ __device__ __forceinline__ void stage_rc(int b, int& R, int& C) { const int st = b / 1024, sb = b % 1024, swz = sb ^ (((sb >> 9) & 1) << 5); R = (st >> 1) * 16 + swz / 64; C = (st & 1) * 32 + (swz % 64) / 2; }
__host__ __device__ __forceinline__ int perm32(int rho) { const int n = rho >> 4, i = rho & 15; return 8 * (i >> 2) + 4 * n + (i & 3); }
__host__ __device__ __forceinline__ int g8(int r) { const int t = r >> 1; return 4 * (((t + 2) >> 2) & 1) + (t & 1) + 2 * ((t >> 2) & 1); }
__host__ __device__ __forceinline__ void stage_rc8(int b, int& R, int& Cb) { const int blk = b >> 11, ri = (b >> 7) & 15, slot = (b >> 4) & 7; R = blk * 16 + ri; Cb = 16 * (slot ^ g8(ri)); }

struct Unit { int pm, pn; };
struct Gemm { const void* A; const void* Bt; int M, N, K, kb; };

struct StaticOrder {
    static constexpr bool GATHER = false;
    int nM, nN, nwg, G, c; const char* A; const char* B; size_t tstep;
    __device__ void init(const Gemm& g, int G_, int c_) { nM = g.M / BM; nN = g.N / BM; nwg = nM * nN; G = G_; c = c_; A = (const char*)g.A; B = (const char*)g.Bt; tstep = (size_t)BM * g.kb; }
    __device__ bool next(int i, Unit& u) const {
        const long L = (long)i * G + c; if (L >= nwg) return false;
        int wgid = (int)L; { const int q = nwg / NXCD, r = nwg % NXCD, xcd = wgid % NXCD, off = wgid / NXCD; wgid = (xcd < r ? xcd * (q + 1) : r * (q + 1) + (xcd - r) * q) + off; }
        const int nig = WGM * nN, gid = wgid / nig, fm = gid * WGM, gsz = (nM - fm) < WGM ? (nM - fm) : WGM;
        u.pm = fm + ((wgid % nig) % gsz); u.pn = (wgid % nig) / gsz; return true;
    }
    __device__ __forceinline__ const char* a_ptr(const Unit& u) const { return A + (size_t)u.pm * tstep; }
    __device__ __forceinline__ const char* b_ptr(const Unit& u) const { return B + (size_t)u.pn * tstep; }
};
struct MoeOrder : StaticOrder {
    const PG8_LAS int* t2e; size_t estride;
    __device__ void init_moe(const Gemm& g, int nMdyn, int G_, int c_, const PG8_LAS int* t2e_, size_t estride_) { init(g, G_, c_); nM = nMdyn; nwg = nM * nN; t2e = t2e_; estride = estride_; }
    __device__ __forceinline__ const char* b_ptr(const Unit& u) const { return B + (size_t)__builtin_amdgcn_readfirstlane(t2e[u.pm]) * estride + (size_t)u.pn * tstep; }
};
struct MoeGatherOrder : MoeOrder {
    static constexpr bool GATHER = true;
    const PG8_LAS int* gmap;
    __device__ __forceinline__ const char* a_ptr(const Unit&) const { return A; }
};

template <class Epi, class Sched, bool ALIGN_EPI = true, bool F8 = false>
__device__ __forceinline__ void gemm_phase(PG8_LAS unsigned char* lds, const Gemm g, const Sched& S, const Epi& E) {
    const int tid = threadIdx.x, wid = __builtin_amdgcn_readfirstlane(tid >> 6), lane = tid & 63, wr = wid >> 2, wc = wid & 3, fr = lane & 15, fq = lane >> 4;
    const int KB = g.kb, nt = KB / 128;
    unsigned voffA[2], voffB[2], voffA1[2] = {0u, 0u}, gC[2]; int gR[2];
#pragma unroll
    for (int i = 0; i < 2; ++i) { int R, Cb; if (F8) stage_rc8(tid * 16 + i * 8192, R, Cb); else { int C; stage_rc(tid * 16 + i * 8192, R, C); Cb = 2 * C; }
        const int Rb = Epi::PERM ? ((R & ~31) + perm32(R & 31)) : R;
        voffA[i] = (unsigned)(R * KB + Cb); voffB[i] = (unsigned)(Rb * KB + Cb); gR[i] = R; gC[i] = (unsigned)Cb; }
    const size_t kstep = (size_t)128;
    const size_t hstep = (size_t)HALF * KB;
    const unsigned ldsw = (unsigned)wid * 1024u;
    int aoffk[2], boffk[2];
    if (F8) { const int la0 = fr * 128 + 16 * ((2 * fq) ^ g8(fr)); aoffk[0] = wr * 8192 + la0; aoffk[1] = wr * 8192 + (la0 ^ 16); boffk[0] = wc * 4096 + la0; boffk[1] = wc * 4096 + (la0 ^ 16); }
    else { const int aoff = lds_byte(wr * 64 + fr, fq * 8), boff = lds_byte(wc * 32 + fr, fq * 8); aoffk[0] = aoff; aoffk[1] = aoff + 1024; boffk[0] = boff; boffk[1] = boff + 1024; }
#define PG8_SA(b, h) (((b) * 2 + (h)) * HTB)
#define PG8_SB(b, h) ((4 + (b) * 2 + (h)) * HTB)
#define PG8_STAGE(bufoff, gbase, voff) do { _Pragma("unroll") for (int _i = 0; _i < 2; ++_i) \
        __builtin_amdgcn_global_load_lds((const unsigned*)((const char*)(gbase) + (voff)[_i]), (PG8_LAS unsigned*)(lds + (bufoff) + ldsw + _i * 8192), 16, 0, 0); } while (0)
#define PG8_GLOAD(ui_) do { if constexpr (Sched::GATHER) { _Pragma("unroll") for (int _i = 0; _i < 2; ++_i) { \
        voffA[_i] = (unsigned)S.gmap[(ui_) * 256 + gR[_i]] * (unsigned)KB + gC[_i]; voffA1[_i] = (unsigned)S.gmap[(ui_) * 256 + 128 + gR[_i]] * (unsigned)KB + gC[_i]; } } } while (0)
#define PG8_STAGE_A(bufoff, gbase, half) do { if constexpr (Sched::GATHER) { if (half) PG8_STAGE(bufoff, gbase, voffA1); else PG8_STAGE(bufoff, gbase, voffA); } \
        else PG8_STAGE(bufoff, (gbase) + (half) * hstep, voffA); } while (0)
#define PG8_LD16(off) (*(const PG8_LAS v4i_t*)(lds + (off)))
#define PG8_LDA(dst, b, h) do { _Pragma("unroll") for (int m = 0; m < 4; ++m) dst[m] = __builtin_shufflevector(PG8_LD16(PG8_SA(b, h) + aoffk[0] + m * 2048), PG8_LD16(PG8_SA(b, h) + aoffk[1] + m * 2048), 0, 1, 2, 3, 4, 5, 6, 7); } while (0)
#define PG8_LDB(dst, b, h) do { _Pragma("unroll") for (int n = 0; n < 2; ++n) dst[n] = __builtin_shufflevector(PG8_LD16(PG8_SB(b, h) + boffk[0] + n * 2048), PG8_LD16(PG8_SB(b, h) + boffk[1] + n * 2048), 0, 1, 2, 3, 4, 5, 6, 7); } while (0)
#define PG8_BFLO(x) __builtin_bit_cast(bf16x8, __builtin_shufflevector(x, x, 0, 1, 2, 3))
#define PG8_BFHI(x) __builtin_bit_cast(bf16x8, __builtin_shufflevector(x, x, 4, 5, 6, 7))
#ifdef F8_PLAIN
#define F8_MMA_ONE(c, w, a) do { _Pragma("unroll") for (int q_ = 0; q_ < 4; ++q_) { const long wq_ = ((long)(unsigned)(w)[2 * q_ + 1] << 32) | (unsigned)(w)[2 * q_], aq_ = ((long)(unsigned)(a)[2 * q_ + 1] << 32) | (unsigned)(a)[2 * q_]; \
        c = __builtin_amdgcn_mfma_f32_16x16x32_fp8_fp8(wq_, aq_, c, 0, 0, 0); } } while (0)
#else
#define F8_MMA_ONE(c, w, a) asm volatile("v_mfma_scale_f32_16x16x128_f8f6f4 %0, %1, %2, %0, %3, %4 op_sel_hi:[0,0,0]" : "+v"(c) : "v"(w), "v"(a), "v"(f8sw), "v"(f8sa))
#endif
#define PG8_MMA(ai, bj, At, Bt) do { __builtin_amdgcn_s_setprio(1); _Pragma("unroll") for (int m = 0; m < 4; ++m) _Pragma("unroll") for (int n = 0; n < 2; ++n) { \
        if constexpr (F8) { F8_MMA_ONE(acc[ai][bj][m][n], Bt[n], At[m]); } \
        else { acc[ai][bj][m][n] = __builtin_amdgcn_mfma_f32_16x16x32_bf16(PG8_BFLO(Bt[n]), PG8_BFLO(At[m]), acc[ai][bj][m][n], 0, 0, 0); \
               acc[ai][bj][m][n] = __builtin_amdgcn_mfma_f32_16x16x32_bf16(PG8_BFHI(Bt[n]), PG8_BFHI(At[m]), acc[ai][bj][m][n], 0, 0, 0); } } __builtin_amdgcn_s_setprio(0); } while (0)
#define PG8_WAIT_V(n) asm volatile("s_waitcnt vmcnt(" #n ")" ::: "memory")
#define PG8_WAIT_L(n) asm volatile("s_waitcnt lgkmcnt(" #n ")" ::: "memory")
#define PG8_BAR __builtin_amdgcn_s_barrier()
#define PG8_SCHED __builtin_amdgcn_sched_barrier(0)
    Unit cur, nxt; int ui = 0;
    if (!S.next(0, cur)) return;
    f32x4 acc[2][2][4][2];
#pragma unroll
    for (int a = 0; a < 2; ++a)
#pragma unroll
        for (int b = 0; b < 2; ++b)
#pragma unroll
            for (int m = 0; m < 4; ++m)
#pragma unroll
                for (int n = 0; n < 2; ++n) acc[a][b][m][n] = (f32x4){0.f, 0.f, 0.f, 0.f};
    const int f8sw = F8_SCALE_W, f8sa = F8_SCALE_A; (void)f8sw; (void)f8sa;
    v8i_t At[4], B0[2], B1[2];
    const char* cA = S.a_ptr(cur); const char* cB = S.b_ptr(cur);
    PG8_GLOAD(0);
    PG8_STAGE(PG8_SB(0, 0), cB, voffB); PG8_STAGE(PG8_SB(0, 1), cB + hstep, voffB); PG8_STAGE_A(PG8_SA(0, 0), cA, 0); PG8_STAGE_A(PG8_SA(0, 1), cA, 1);
    if (wr == 1) PG8_BAR;
    PG8_WAIT_V(2); PG8_BAR;
    PG8_STAGE(PG8_SB(1, 0), cB + kstep, voffB); PG8_STAGE_A(PG8_SA(1, 0), cA + kstep, 0); PG8_STAGE(PG8_SB(1, 1), cB + hstep + kstep, voffB);
    PG8_WAIT_V(6); PG8_BAR;
    for (;;) {
        const bool has_next = S.next(ui + 1, nxt);
        const char* nA = has_next ? S.a_ptr(nxt) : cA; const char* nB = has_next ? S.b_ptr(nxt) : cB;
#pragma unroll 1
        for (int t = 0; t < nt; t += 2) {
            const bool last = (t == nt - 2);
            const char* a1 = cA + (size_t)(t + 1) * kstep;
            const char* a2 = last ? nA : cA + (size_t)(t + 2) * kstep; const char* b2 = last ? nB : cB + (size_t)(t + 2) * kstep;
            const char* a3 = a2 + kstep; const char* b3 = b2 + kstep;
            PG8_LDB(B0, 0, 0); PG8_LDB(B1, 0, 1); PG8_SCHED; PG8_LDA(At, 0, 0); PG8_STAGE_A(PG8_SA(1, 1), a1, 1);
            if (last && has_next) PG8_GLOAD(ui + 1);
            PG8_WAIT_V(8); PG8_WAIT_L(0); PG8_BAR; PG8_MMA(0, 0, At, B0); PG8_MMA(0, 1, At, B1); PG8_BAR; PG8_SCHED;
            PG8_LDA(At, 0, 1); PG8_STAGE(PG8_SB(0, 0), b2, voffB); PG8_STAGE(PG8_SB(0, 1), b2 + hstep, voffB); PG8_STAGE_A(PG8_SA(0, 0), a2, 0);
            PG8_WAIT_V(8); PG8_WAIT_L(0); PG8_BAR; PG8_MMA(1, 0, At, B0); PG8_MMA(1, 1, At, B1); PG8_BAR; PG8_SCHED;
            PG8_LDB(B0, 1, 0); PG8_LDB(B1, 1, 1); PG8_SCHED; PG8_LDA(At, 1, 0); PG8_STAGE_A(PG8_SA(0, 1), a2, 1);
            PG8_WAIT_V(8); PG8_WAIT_L(0); PG8_BAR; PG8_MMA(0, 0, At, B0); PG8_MMA(0, 1, At, B1); PG8_BAR; PG8_SCHED;
            PG8_LDA(At, 1, 1); PG8_STAGE(PG8_SB(1, 0), b3, voffB); PG8_STAGE(PG8_SB(1, 1), b3 + hstep, voffB); PG8_STAGE_A(PG8_SA(1, 0), a3, 0);
            PG8_WAIT_V(8); PG8_WAIT_L(0); PG8_BAR; PG8_MMA(1, 0, At, B0); PG8_MMA(1, 1, At, B1); PG8_BAR; PG8_SCHED;
        }
        if constexpr (ALIGN_EPI) { if (wr == 0) PG8_BAR; }
        if constexpr (F8) asm volatile("s_nop 7\n\ts_nop 7" ::: "memory");
        E(acc, cur, wr, wc, fr, fq);
        if (!has_next) break;
#pragma unroll
        for (int a = 0; a < 2; ++a)
#pragma unroll
            for (int b = 0; b < 2; ++b)
#pragma unroll
                for (int m = 0; m < 4; ++m)
#pragma unroll
                    for (int n = 0; n < 2; ++n) acc[a][b][m][n] = (f32x4){0.f, 0.f, 0.f, 0.f};
        cur = nxt; cA = nA; cB = nB; ++ui;
        if constexpr (ALIGN_EPI) { if (wr == 1) PG8_BAR; }
    }
    PG8_WAIT_V(0);
    if constexpr (!ALIGN_EPI) { if (wr == 0) PG8_BAR; }
    PG8_BAR;
#undef PG8_SA
#undef PG8_SB
#undef PG8_STAGE
#undef PG8_LDA
#undef PG8_LDB
#undef PG8_MMA
#undef PG8_LD16
#undef PG8_GLOAD
#undef PG8_STAGE_A
#undef PG8_BFLO
#undef PG8_BFHI
#undef PG8_WAIT_V
#undef PG8_WAIT_L
#undef PG8_BAR
#undef PG8_SCHED
}

typedef f32x4 Acc[2][2][4][2];
struct EpiInProj {
    static constexpr bool PERM = true;
    bf16_t *Q, *Kb, *Vb, *XR, *XG, *GA, *GR; int pn0;
    __device__ __forceinline__ void operator()(const Acc& acc, const Unit& u, int wr, int wc, int fr, int fq) const {
        const int pn = pn0 == 0 ? (u.pn < 10 ? u.pn : u.pn + 4) : u.pn + 10; bf16_t* base; int ldc, colt, act;
        if (pn < 4) { base = Q; ldc = 1024; colt = pn * 256; act = 0; }
        else if (pn == 4) { base = Kb; ldc = 256; colt = 0; act = 0; }
        else if (pn == 5) { base = Vb; ldc = 256; colt = 0; act = 0; }
        else if (pn < 10) { base = XR; ldc = 1024; colt = (pn - 6) * 256; act = 0; }
        else if (pn < 14) { base = XG; ldc = 1024; colt = (pn - 10) * 256; act = 1; }
        else if (pn < 18) { base = GA; ldc = 1024; colt = (pn - 14) * 256; act = 2; }
        else { base = GR; ldc = 1024; colt = (pn - 18) * 256; act = 2; }
        const int row0 = u.pm * BM + wr * 64 + fr, col0 = colt + wc * 32 + 8 * fq;
#pragma unroll
        for (int ai = 0; ai < 2; ++ai)
#pragma unroll
            for (int m = 0; m < 4; ++m) { bf16_t* rowp = base + (size_t)(row0 + ai * HALF + m * 16) * ldc + col0;
#pragma unroll
                for (int bj = 0; bj < 2; ++bj) { f32x4 v0 = acc[ai][bj][m][0], v1 = acc[ai][bj][m][1];
                    if (act == 1) {
#pragma unroll
                        for (int e = 0; e < 4; ++e) { v0[e] = gelu_tanh_(v0[e]); v1[e] = gelu_tanh_(v1[e]); } }
                    else if (act == 2) {
#pragma unroll
                        for (int e = 0; e < 4; ++e) { v0[e] = sigmoidf_(v0[e]); v1[e] = sigmoidf_(v1[e]); } }
                    u32x4 w; w.x = cvt_pk_bf16(v0[0], v0[1]); w.y = cvt_pk_bf16(v0[2], v0[3]); w.z = cvt_pk_bf16(v1[0], v1[1]); w.w = cvt_pk_bf16(v1[2], v1[3]);
                    *(u32x4*)(rowp + bj * HALF) = w; } }
    }
};
struct EpiF8x8 {
    static constexpr bool PERM = true;
    unsigned char* O; int ldc;
    __device__ __forceinline__ void operator()(const Acc& acc, const Unit& u, int wr, int wc, int fr, int fq) const {
        const int row0 = u.pm * BM + wr * 64 + fr, col0 = u.pn * BM + wc * 32 + 8 * fq;
#pragma unroll
        for (int ai = 0; ai < 2; ++ai)
#pragma unroll
            for (int m = 0; m < 4; ++m) { unsigned char* rowp = O + (size_t)(row0 + ai * HALF + m * 16) * ldc + col0;
#pragma unroll
                for (int bj = 0; bj < 2; ++bj) { const f32x4 v0 = acc[ai][bj][m][0] * 8.0f, v1 = acc[ai][bj][m][1] * 8.0f;
                    u32x2 w = {0u, 0u}; w.x = __builtin_amdgcn_cvt_pk_fp8_f32(v0[0], v0[1], w.x, false); w.x = __builtin_amdgcn_cvt_pk_fp8_f32(v0[2], v0[3], w.x, true);
                    w.y = __builtin_amdgcn_cvt_pk_fp8_f32(v1[0], v1[1], w.y, false); w.y = __builtin_amdgcn_cvt_pk_fp8_f32(v1[2], v1[3], w.y, true);
                    *(u32x2*)(rowp + bj * HALF) = w; } }
    }
};
template <int MODE, bool O8 = false, bool P8 = false> struct EpiGate {
    static constexpr bool PERM = true;
    const bf16_t* __restrict__ G; const bf16_t* __restrict__ P; bf16_t* __restrict__ O;
    __device__ __forceinline__ void operator()(const Acc& acc, const Unit& u, int wr, int wc, int fr, int fq) const {
        const int row0 = u.pm * BM + wr * 64 + fr, col0 = u.pn * BM + wc * 32 + 8 * fq;
#pragma unroll
        for (int ai = 0; ai < 2; ++ai) {
            u32x4 g[4][2], p[4][2]; u32x2 p8[4][2];
#pragma unroll
            for (int m = 0; m < 4; ++m)
#pragma unroll
                for (int bj = 0; bj < 2; ++bj) { const size_t ro = (size_t)(row0 + ai * HALF + m * 16) * 1024 + col0 + bj * HALF; g[m][bj] = *(const u32x4*)(G + ro); if (MODE == 1) { if constexpr (P8) p8[m][bj] = *(const u32x2*)((const unsigned char*)P + ro); else p[m][bj] = *(const u32x4*)(P + ro); } }
#pragma unroll
            for (int m = 0; m < 4; ++m)
#pragma unroll
                for (int bj = 0; bj < 2; ++bj) { const size_t ro = (size_t)(row0 + ai * HALF + m * 16) * 1024 + col0 + bj * HALF; const f32x4 v0 = acc[ai][bj][m][0], v1 = acc[ai][bj][m][1]; const u32x4 gg = g[m][bj];
                    float o[8];
                    o[0] = bflo(gg.x) * v0[0]; o[1] = bfhi(gg.x) * v0[1]; o[2] = bflo(gg.y) * v0[2]; o[3] = bfhi(gg.y) * v0[3];
                    o[4] = bflo(gg.z) * v1[0]; o[5] = bfhi(gg.z) * v1[1]; o[6] = bflo(gg.w) * v1[2]; o[7] = bfhi(gg.w) * v1[3];
                    if (MODE == 1) {
                        if constexpr (P8) { const u32x2 pq = p8[m][bj]; const f32x2 a_ = __builtin_amdgcn_cvt_pk_f32_fp8(pq.x, false), b_ = __builtin_amdgcn_cvt_pk_f32_fp8(pq.x, true), c_ = __builtin_amdgcn_cvt_pk_f32_fp8(pq.y, false), d_ = __builtin_amdgcn_cvt_pk_f32_fp8(pq.y, true);
                            o[0] += a_[0] * 0.0625f; o[1] += a_[1] * 0.0625f; o[2] += b_[0] * 0.0625f; o[3] += b_[1] * 0.0625f; o[4] += c_[0] * 0.0625f; o[5] += c_[1] * 0.0625f; o[6] += d_[0] * 0.0625f; o[7] += d_[1] * 0.0625f; }
                        else { const u32x4 pp = p[m][bj];
                        o[0] += bflo(pp.x); o[1] += bfhi(pp.x); o[2] += bflo(pp.y); o[3] += bfhi(pp.y); o[4] += bflo(pp.z); o[5] += bfhi(pp.z); o[6] += bflo(pp.w); o[7] += bfhi(pp.w); } }
                    if constexpr (O8 && MODE == 0) {
#pragma unroll
                        for (int e_ = 0; e_ < 8; ++e_) o[e_] *= 16.0f; }
                    if constexpr (O8) { u32x2 w8 = {0u, 0u}; w8.x = __builtin_amdgcn_cvt_pk_fp8_f32(o[0], o[1], w8.x, false); w8.x = __builtin_amdgcn_cvt_pk_fp8_f32(o[2], o[3], w8.x, true);
                        w8.y = __builtin_amdgcn_cvt_pk_fp8_f32(o[4], o[5], w8.y, false); w8.y = __builtin_amdgcn_cvt_pk_fp8_f32(o[6], o[7], w8.y, true); *(u32x2*)((unsigned char*)O + ro) = w8; }
                    else {
                    u32x4 w; w.x = cvt_pk_bf16(o[0], o[1]); w.y = cvt_pk_bf16(o[2], o[3]); w.z = cvt_pk_bf16(o[4], o[5]); w.w = cvt_pk_bf16(o[6], o[7]);
                    *(u32x4*)(O + ro) = w; } }
        }
    }
};
struct EpiResid {
    static constexpr bool PERM = true;
    const float* __restrict__ X; bf16_t* __restrict__ H;
    __device__ __forceinline__ void operator()(const Acc& acc, const Unit& u, int wr, int wc, int fr, int fq) const {
        const int row0 = u.pm * BM + wr * 64 + fr, col0 = u.pn * BM + wc * 32 + 8 * fq;
#pragma unroll
        for (int ai = 0; ai < 2; ++ai) {
            f32x4 xv[4][2][2];
#pragma unroll
            for (int m = 0; m < 4; ++m)
#pragma unroll
                for (int bj = 0; bj < 2; ++bj)
#pragma unroll
                    for (int n = 0; n < 2; ++n) xv[m][bj][n] = *(const f32x4*)(X + (size_t)(row0 + ai * HALF + m * 16) * 1024 + col0 + bj * HALF + n * 4);
#pragma unroll
            for (int m = 0; m < 4; ++m)
#pragma unroll
                for (int bj = 0; bj < 2; ++bj) { const size_t o = (size_t)(row0 + ai * HALF + m * 16) * 1024 + col0 + bj * HALF; const f32x4 v0 = xv[m][bj][0] + acc[ai][bj][m][0], v1 = xv[m][bj][1] + acc[ai][bj][m][1];
                    u32x4 w; w.x = cvt_pk_bf16(v0[0], v0[1]); w.y = cvt_pk_bf16(v0[2], v0[3]); w.z = cvt_pk_bf16(v1[0], v1[1]); w.w = cvt_pk_bf16(v1[2], v1[3]);
                    *(u32x4*)(H + o) = w; }
        }
    }
};
struct EpiSwiglu {
    static constexpr bool PERM = true;
    const PG8_LAS int* t2e; const float* bgu; unsigned char* ACT; const float* srs;
    __device__ __forceinline__ void operator()(const Acc& acc, const Unit& u, int wr, int wc, int fr, int fq) const {
        const int e = __builtin_amdgcn_readfirstlane(t2e[u.pm]); const int row0 = u.pm * BM + wr * 64 + fr, j0 = u.pn * 128 + wc * 32 + 8 * fq;
        const float* bg = bgu + (size_t)e * 2048 + j0; const float* bu = bg + 1024;
        const f32x4 bg0 = *(const f32x4*)bg, bg1 = *(const f32x4*)(bg + 4), bu0 = *(const f32x4*)bu, bu1 = *(const f32x4*)(bu + 4);
        float rsv[2][4];
#pragma unroll
        for (int ai = 0; ai < 2; ++ai)
#pragma unroll
            for (int m = 0; m < 4; ++m) rsv[ai][m] = srs[row0 + ai * HALF + m * 16];
#pragma unroll
        for (int ai = 0; ai < 2; ++ai)
#pragma unroll
            for (int m = 0; m < 4; ++m) { const int row = row0 + ai * HALF + m * 16; const float sc = F8_ACC_SCALE * rsv[ai][m];
                float o[8];
#pragma unroll
                for (int n = 0; n < 2; ++n)
#pragma unroll
                    for (int q = 0; q < 4; ++q) { float gt = acc[ai][0][m][n][q] * sc + (n ? bg1[q] : bg0[q]); float up = acc[ai][1][m][n][q] * sc + (n ? bu1[q] : bu0[q]);
                        gt = fminf(gt, 7.0f); up = fminf(fmaxf(up, -7.0f), 7.0f); o[n * 4 + q] = (up + 1.0f) * (gt * sigmoidf_(1.702f * gt)); }
                u32x2 w = {0u, 0u}; w.x = __builtin_amdgcn_cvt_pk_fp8_f32(o[0], o[1], w.x, false); w.x = __builtin_amdgcn_cvt_pk_fp8_f32(o[2], o[3], w.x, true);
                w.y = __builtin_amdgcn_cvt_pk_fp8_f32(o[4], o[5], w.y, false); w.y = __builtin_amdgcn_cvt_pk_fp8_f32(o[6], o[7], w.y, true);
                *(u32x2*)(ACT + (size_t)row * 1024 + j0) = w; }
    }
};
struct EpiDown {
    static constexpr bool PERM = true;
    const PG8_LAS int* t2e; const float* bdn; const u32x2* smeta; unsigned char* Y;
    __device__ __forceinline__ void operator()(const Acc& acc, const Unit& u, int wr, int wc, int fr, int fq) const {
        const int e = __builtin_amdgcn_readfirstlane(t2e[u.pm]); const int row0 = u.pm * BM + wr * 64 + fr, col0 = u.pn * BM + wc * 32 + 8 * fq;
        f32x4 bv[2][2];
#pragma unroll
        for (int bj = 0; bj < 2; ++bj)
#pragma unroll
            for (int n = 0; n < 2; ++n) bv[bj][n] = *(const f32x4*)(bdn + (size_t)e * 1024 + col0 + bj * HALF + 4 * n);
        int tkv[2][4]; float gtv[2][4];
#pragma unroll
        for (int ai = 0; ai < 2; ++ai)
#pragma unroll
            for (int m = 0; m < 4; ++m) { const u32x2 mt = smeta[row0 + ai * HALF + m * 16]; tkv[ai][m] = (int)mt.x; gtv[ai][m] = __uint_as_float(mt.y); }
#pragma unroll
        for (int ai = 0; ai < 2; ++ai)
#pragma unroll
            for (int m = 0; m < 4; ++m) { const int tk = tkv[ai][m]; const float gt = gtv[ai][m];
                if (tk >= 0) { unsigned char* rowp = Y + (size_t)(row0 + ai * HALF + m * 16) * 1024 + col0; const float g16 = gt * 16.0f;
#pragma unroll
                    for (int bj = 0; bj < 2; ++bj) { const f32x4 v0 = (acc[ai][bj][m][0] * F8_ACC_SCALE + bv[bj][0]) * g16, v1 = (acc[ai][bj][m][1] * F8_ACC_SCALE + bv[bj][1]) * g16;
                        u32x2 w = {0u, 0u}; w.x = __builtin_amdgcn_cvt_pk_fp8_f32(v0[0], v0[1], w.x, false); w.x = __builtin_amdgcn_cvt_pk_fp8_f32(v0[2], v0[3], w.x, true);
                        w.y = __builtin_amdgcn_cvt_pk_fp8_f32(v1[0], v1[1], w.y, false); w.y = __builtin_amdgcn_cvt_pk_fp8_f32(v1[2], v1[3], w.y, true);
                        *(u32x2*)(rowp + bj * HALF) = w; } } }
    }
};
struct EpiPle {
    static constexpr bool PERM = false;
    float* __restrict__ OUT; const float* __restrict__ rstd; const unsigned char* __restrict__ PP; const bf16_t* __restrict__ H2;
    __device__ __forceinline__ void operator()(const Acc& acc, const Unit& u, int wr, int wc, int fr, int fq) const {
        const int row0 = u.pm * BM + wr * 64 + fr, col0 = u.pn * BM + wc * 32 + 4 * fq;
        float rsv[2][4];
#pragma unroll
        for (int ai = 0; ai < 2; ++ai)
#pragma unroll
            for (int m = 0; m < 4; ++m) rsv[ai][m] = rstd[row0 + ai * HALF + m * 16];
#pragma unroll
        for (int ai = 0; ai < 2; ++ai) {
            u32x2 hv[4][2][2]; unsigned pv[4][2][2];
#pragma unroll
            for (int m = 0; m < 4; ++m)
#pragma unroll
                for (int bj = 0; bj < 2; ++bj)
#pragma unroll
                    for (int n = 0; n < 2; ++n) { const size_t o = (size_t)(row0 + ai * HALF + m * 16) * 1024 + col0 + bj * HALF + n * 16; hv[m][bj][n] = *(const u32x2*)(H2 + o); pv[m][bj][n] = *(const unsigned*)(PP + o); }
#pragma unroll
            for (int m = 0; m < 4; ++m)
#pragma unroll
                for (int bj = 0; bj < 2; ++bj)
#pragma unroll
                    for (int n = 0; n < 2; ++n) { const size_t o = (size_t)(row0 + ai * HALF + m * 16) * 1024 + col0 + bj * HALF + n * 16; const u32x2 h = hv[m][bj][n]; const unsigned p = pv[m][bj][n]; const f32x4 a = acc[ai][bj][m][n]; const float rs = rsv[ai][m];
                        const f32x2 p01 = __builtin_amdgcn_cvt_pk_f32_fp8(p, false), p23 = __builtin_amdgcn_cvt_pk_f32_fp8(p, true);
                        f32x4 r; r[0] = bflo(h.x) + sigmoidf_(a[0] * rs) * (p01[0] * 0.125f); r[1] = bfhi(h.x) + sigmoidf_(a[1] * rs) * (p01[1] * 0.125f); r[2] = bflo(h.y) + sigmoidf_(a[2] * rs) * (p23[0] * 0.125f); r[3] = bfhi(h.y) + sigmoidf_(a[3] * rs) * (p23[1] * 0.125f);
                        *(f32x4*)(OUT + o) = r; }
        }
    }
};
}

namespace attn {
constexpr int D = 128, NW = 8, QBLK = 32, KVBLK = 64;
constexpr float SCALE = 0.088388347648318440f;
constexpr float THR = 8.f;
constexpr int SDEPTH = 1;
constexpr int LDQ = 1024, LDK = 256, LDO = 1024;
constexpr size_t SHM_V = KVBLK * D * 2, SHM_K = KVBLK * D * 2, SHM_ATTN = 2 * SHM_V + 2 * SHM_K + NW * 64 * 4;
#define KSWZ(row, colB) ((row) * 256 + ((colB) ^ (((row) & 7) << 4)))
#define SBAR() __builtin_amdgcn_sched_barrier(0)
__device__ __forceinline__ int crow(int r, int hi) { return (r & 3) + 8 * (r >> 2) + 4 * hi; }
__device__ __forceinline__ unsigned cvtpk(float lo, float hi) { unsigned r; asm volatile("v_cvt_pk_bf16_f32 %0, %1, %2" : "=v"(r) : "v"(lo), "v"(hi)); return r; }
__device__ __forceinline__ void partialSM(f32x16& p0, f32x16& p1, float& m_reg, float& mn, float& alpha) {
  constexpr float C = SCALE * 1.4426950408889634f;
  float pmax = p0[0]; for (int r = 1; r < 16; ++r) pmax = fmaxf(pmax, p0[r]); for (int r = 0; r < 16; ++r) pmax = fmaxf(pmax, p1[r]);
  { auto rr = __builtin_amdgcn_permlane32_swap(__float_as_uint(pmax), __float_as_uint(pmax), false, false);
    pmax = fmaxf(__uint_as_float(rr[0]), __uint_as_float(rr[1])); }
  if (__builtin_expect(__all(pmax - m_reg <= THR / SCALE), 1)) { mn = m_reg; alpha = 1.f; }
  else { mn = fmaxf(m_reg, pmax); alpha = __builtin_amdgcn_exp2f((m_reg - mn) * C); m_reg = mn; }
  float mnC = -mn * C;
  for (int r = 0; r < 16; ++r) p0[r] = fmaf(p0[r], C, mnC); for (int r = 0; r < 16; ++r) p1[r] = fmaf(p1[r], C, mnC);
  for (int r = 0; r < 16; ++r) p0[r] = __builtin_amdgcn_exp2f(p0[r]);
}
__device__ __forceinline__ void finishSM(f32x16& p0, f32x16& p1, float alpha, float& l_reg, bf16x8& pa0, bf16x8& pa1, bf16x8& pa2, bf16x8& pa3) {
  for (int r = 0; r < 16; ++r) p1[r] = __builtin_amdgcn_exp2f(p1[r]);
  float ps = 0; for (int r = 0; r < 16; ++r) ps += p0[r]; for (int r = 0; r < 16; ++r) ps += p1[r];
  { auto rr = __builtin_amdgcn_permlane32_swap(__float_as_uint(ps), __float_as_uint(ps), false, false);
    ps = __uint_as_float(rr[0]) + __uint_as_float(rr[1]); }
  l_reg = l_reg * alpha + ps;
#define PK4(P, BASE, OUT) do { unsigned a0 = cvtpk(P[BASE + 0], P[BASE + 1]), a1 = cvtpk(P[BASE + 2], P[BASE + 3]);   \
    unsigned b0 = cvtpk(P[BASE + 4], P[BASE + 5]), b1 = cvtpk(P[BASE + 6], P[BASE + 7]);                              \
    auto r0 = __builtin_amdgcn_permlane32_swap(a0, b0, false, false); auto r1 = __builtin_amdgcn_permlane32_swap(a1, b1, false, false); \
    u32x4 w = {r0[0], r1[0], r0[1], r1[1]}; OUT = *reinterpret_cast<bf16x8*>(&w); } while (0)
  PK4(p0, 0, pa0); PK4(p0, 8, pa1); PK4(p1, 0, pa2); PK4(p1, 8, pa3);
#undef PK4
}
__device__ __forceinline__ void qkt(f32x16& p0, f32x16& p1, const bf16* Ks, const bf16x8* qr, int r32, int hi) {
  p0 = f32x16{}; p1 = f32x16{};
  for (int d0 = 0; d0 < 8; ++d0) { int cb = (d0 * 16 + hi * 8) * 2;
    bf16x8 b0 = *reinterpret_cast<const bf16x8*>((const char*)Ks + KSWZ(r32, cb));
    bf16x8 b1 = *reinterpret_cast<const bf16x8*>((const char*)Ks + KSWZ(32 + r32, cb));
    p0 = __builtin_amdgcn_mfma_f32_32x32x16_bf16(b0, qr[d0], p0, 0, 0, 0);
    p1 = __builtin_amdgcn_mfma_f32_32x32x16_bf16(b1, qr[d0], p1, 0, 0, 0); }
}
__device__ __forceinline__ int v_st(int k, int c) { const int kk = (k & ~0xC) | ((k & 4) << 1) | ((k & 8) >> 1); return ((kk >> 3) * 4 + (c >> 5)) * 512 + ((kk & 7) * 32 + (c & 31)) * 2; }
__device__ __forceinline__ int v_rd_base(int lane) { return ((lane & 3) << 3) | (((lane >> 2) & 3) << 6) | (((lane >> 4) & 1) << 5) | (((lane >> 5) & 1) << 8); }
constexpr int v_rd_off(int d0, int ks, int half) { return d0 * 512 + ks * 4096 + half * 2048; }
template <int OFF> __device__ __forceinline__ s16x4 tr_read(int vb) {
  s16x4 r; asm volatile("ds_read_b64_tr_b16 %0, %1 offset:%2" : "=&v"(r) : "v"(vb), "i"(OFF) : "memory"); return r;
}
template <int D0> __device__ __forceinline__ void pv_one(f32x16& od, int vb, bf16x8 pa0, bf16x8 pa1, bf16x8 pa2, bf16x8 pa3) {
  const s16x4 l0 = tr_read<v_rd_off(D0, 0, 0)>(vb), h0 = tr_read<v_rd_off(D0, 0, 1)>(vb), l1 = tr_read<v_rd_off(D0, 1, 0)>(vb), h1 = tr_read<v_rd_off(D0, 1, 1)>(vb);
  const s16x4 l2 = tr_read<v_rd_off(D0, 2, 0)>(vb), h2 = tr_read<v_rd_off(D0, 2, 1)>(vb), l3 = tr_read<v_rd_off(D0, 3, 0)>(vb), h3 = tr_read<v_rd_off(D0, 3, 1)>(vb);
  asm volatile("s_waitcnt lgkmcnt(0)" ::: "memory"); SBAR();
#define PK(L, H) (bf16x8){L[0], L[1], L[2], L[3], H[0], H[1], H[2], H[3]}
  od = __builtin_amdgcn_mfma_f32_32x32x16_bf16(pa0, PK(l0, h0), od, 0, 0, 0);
  od = __builtin_amdgcn_mfma_f32_32x32x16_bf16(pa1, PK(l1, h1), od, 0, 0, 0);
  od = __builtin_amdgcn_mfma_f32_32x32x16_bf16(pa2, PK(l2, h2), od, 0, 0, 0);
  od = __builtin_amdgcn_mfma_f32_32x32x16_bf16(pa3, PK(l3, h3), od, 0, 0, 0);
#undef PK
}
__device__ __forceinline__ void pv_d0(f32x16* o, int vb, bf16x8 pa0, bf16x8 pa1, bf16x8 pa2, bf16x8 pa3) {
  pv_one<0>(o[0], vb, pa0, pa1, pa2, pa3); pv_one<1>(o[1], vb, pa0, pa1, pa2, pa3); pv_one<2>(o[2], vb, pa0, pa1, pa2, pa3); pv_one<3>(o[3], vb, pa0, pa1, pa2, pa3);
}
__device__ __forceinline__ void build_rope_table(float* tab, int tid) {
    for (int i = tid; i < 64 * 32; i += 512) { const int id = i >> 5, j = i & 31; const float inv = powf(10000.0f, -(float)(2 * j) / 64.0f); float sn, cs; sincosf((float)id * inv, &sn, &cs); tab[2 * i] = cs; tab[2 * i + 1] = sn; }
}
__device__ __forceinline__ void attn_dense_body(const bf16* Qb, const bf16* __restrict__ Kh, const bf16* __restrict__ Vh, unsigned char* Ob, int seq, char* lds, const float* qn, const float* rtab, int s0) {
  const int tid = threadIdx.x, wid = tid >> 6, lane = tid & 63, r32 = lane & 31, hi = lane >> 5;
  bf16* V_lds = (bf16*)lds; bf16* K_lds = (bf16*)(lds + 2 * SHM_V);
  float* ws = (float*)(lds + 2 * SHM_V + 2 * SHM_K) + wid * 64; float* li_l = ws; float* al_l = ws + 32;
  const int sr = tid >> 4, sc = (tid & 15) * 8, vst0 = v_st(sr, sc), vst1 = vst0 + 8192;
  const unsigned toff = (unsigned)((sr * LDK + sc) * 2);
  const int vb0 = (int)(uintptr_t)V_lds + v_rd_base(lane);
  struct { bf16x8 vs0, vs1, ks0, ks1; } sr_[SDEPTH];
#define SLOAD(i, k0) do { const char* vb_ = (const char*)Vh + (size_t)(k0) * (LDK * 2); const char* kb_ = (const char*)Kh + (size_t)(k0) * (LDK * 2); \
    sr_[i].vs0 = *reinterpret_cast<const bf16x8*>(vb_ + toff); sr_[i].vs1 = *reinterpret_cast<const bf16x8*>(vb_ + 32 * LDK * 2 + toff); \
    sr_[i].ks0 = *reinterpret_cast<const bf16x8*>(kb_ + toff); sr_[i].ks1 = *reinterpret_cast<const bf16x8*>(kb_ + 32 * LDK * 2 + toff); } while (0)
  SLOAD(0, 0);
  float m_reg = -1e30f, l_reg = 0; f32x16 o[4] = {}; bf16x8 qr[8];
  const bf16* Qw = Qb + (long)(wid * QBLK + r32) * LDQ + hi * 8;
#pragma unroll
  for (int d0 = 0; d0 < 8; ++d0) qr[d0] = *reinterpret_cast<const bf16x8*>(Qw + d0 * 16);
  {
    float x[8][8]; float ss = 0.f;
#pragma unroll
    for (int d0 = 0; d0 < 8; ++d0) { const u32x4 w = *reinterpret_cast<const u32x4*>(&qr[d0]);
      x[d0][0] = bflo(w.x); x[d0][1] = bfhi(w.x); x[d0][2] = bflo(w.y); x[d0][3] = bfhi(w.y); x[d0][4] = bflo(w.z); x[d0][5] = bfhi(w.z); x[d0][6] = bflo(w.w); x[d0][7] = bfhi(w.w);
#pragma unroll
      for (int j = 0; j < 8; ++j) ss += x[d0][j] * x[d0][j]; }
    { auto rr = __builtin_amdgcn_permlane32_swap(__float_as_uint(ss), __float_as_uint(ss), false, false); ss = __uint_as_float(rr[0]) + __uint_as_float(rr[1]); }
    const float rstd = 1.0f / sqrtf(ss * (1.f / 128.f) + 1e-6f);
#pragma unroll
    for (int d0 = 0; d0 < 8; ++d0) { const f32x4 g0 = *(const f32x4*)(qn + d0 * 16 + hi * 8), g1 = *(const f32x4*)(qn + d0 * 16 + hi * 8 + 4);
#pragma unroll
      for (int j = 0; j < 4; ++j) { x[d0][j] *= rstd * g0[j]; x[d0][4 + j] *= rstd * g1[j]; } }
    const int spos = s0 + wid * QBLK + r32, rid = spos >> 6, cid = spos & 63;
#pragma unroll
    for (int pr = 0; pr < 4; ++pr) { const int a = (pr & 1) + 4 * (pr >> 1), b = a + 2; const int id = (pr >> 1) ? cid : rid; const float* tp = rtab + 2 * (id * 32 + (pr & 1) * 16 + hi * 8);
      f32x4 t[4];
#pragma unroll
      for (int q = 0; q < 4; ++q) t[q] = *(const f32x4*)(tp + 4 * q);
#pragma unroll
      for (int j = 0; j < 8; ++j) { const float cs = t[j >> 1][(j & 1) * 2], sn = t[j >> 1][(j & 1) * 2 + 1]; const float xa = x[a][j], xb = x[b][j]; x[a][j] = xa * cs - xb * sn; x[b][j] = xb * cs + xa * sn; } }
#pragma unroll
    for (int d0 = 0; d0 < 8; ++d0) { u32x4 w = {cvtpk(x[d0][0], x[d0][1]), cvtpk(x[d0][2], x[d0][3]), cvtpk(x[d0][4], x[d0][5]), cvtpk(x[d0][6], x[d0][7])}; qr[d0] = *reinterpret_cast<bf16x8*>(&w); asm volatile("" : "+v"(qr[d0])); } }
#define SWRITE(b, i) do { *(bf16x8*)((char*)V_lds + (b) * SHM_V + vst0) = sr_[i].vs0;          \
    *(bf16x8*)((char*)V_lds + (b) * SHM_V + vst1) = sr_[i].vs1; int kc = sc * 2;               \
    *(bf16x8*)((char*)K_lds + (b) * SHM_K + KSWZ(sr, kc)) = sr_[i].ks0;                       \
    *(bf16x8*)((char*)K_lds + (b) * SHM_K + KSWZ(sr, kc) + 8192) = sr_[i].ks1; } while (0)
#define SWAIT() do { if constexpr (SDEPTH == 2) asm volatile("s_waitcnt vmcnt(4)" ::: "memory"); else asm volatile("s_waitcnt vmcnt(0)" ::: "memory"); } while (0)
#define RESC(a) do { if (__any((a) < 1.f)) { if (hi == 0) al_l[r32] = (a); asm volatile("s_waitcnt lgkmcnt(0)" ::: "memory"); \
    for (int d = 0; d < 4; ++d) for (int r = 0; r < 16; ++r) o[d][r] *= al_l[crow(r, hi)]; } } while (0)
  f32x16 pA0, pA1, pB0, pB1; float mnA, mnB, alA, alB; bf16x8 pa0, pa1, pa2, pa3; const int NT = seq / KVBLK;
  constexpr int SE = 0, SO = SDEPTH - 1;
  asm volatile("s_waitcnt vmcnt(0)" ::: "memory"); SWRITE(0, SE); __syncthreads();
  qkt(pA0, pA1, K_lds, qr, r32, hi); partialSM(pA0, pA1, m_reg, mnA, alA);
  SLOAD(SO, KVBLK); if constexpr (SDEPTH == 2) { if (2 < NT) SLOAD(SE, 2 * KVBLK); }
  SWAIT(); SWRITE(1, SO); __syncthreads();
  for (int j = 1; j + 1 < NT; j += 2) {
    SBAR(); qkt(pB0, pB1, (bf16*)((char*)K_lds + SHM_K), qr, r32, hi);
    finishSM(pA0, pA1, alA, l_reg, pa0, pa1, pa2, pa3); SBAR();
    SLOAD(SO, (j + SDEPTH) * KVBLK); SBAR();
    pv_d0(o, vb0, pa0, pa1, pa2, pa3); partialSM(pB0, pB1, m_reg, mnB, alB);
    __syncthreads(); SWAIT(); SWRITE(0, SE);
    RESC(alB); __syncthreads();
    SBAR(); qkt(pA0, pA1, K_lds, qr, r32, hi);
    finishSM(pB0, pB1, alB, l_reg, pa0, pa1, pa2, pa3); SBAR();
    if (SDEPTH == 1 || j + 3 < NT) SLOAD(SE, (j + 1 + SDEPTH) * KVBLK); SBAR();
    pv_d0(o, vb0 + (int)SHM_V, pa0, pa1, pa2, pa3); partialSM(pA0, pA1, m_reg, mnA, alA);
    __syncthreads(); SWAIT(); SWRITE(1, SO);
    RESC(alA); __syncthreads();
  }
  SBAR(); qkt(pB0, pB1, (bf16*)((char*)K_lds + SHM_K), qr, r32, hi);
  finishSM(pA0, pA1, alA, l_reg, pa0, pa1, pa2, pa3); SBAR();
  pv_d0(o, vb0, pa0, pa1, pa2, pa3); partialSM(pB0, pB1, m_reg, mnB, alB);
  __syncthreads(); RESC(alB);
  finishSM(pB0, pB1, alB, l_reg, pa0, pa1, pa2, pa3); SBAR();
  pv_d0(o, vb0 + (int)SHM_V, pa0, pa1, pa2, pa3);
  if (hi == 0) li_l[r32] = l_reg; asm volatile("s_waitcnt lgkmcnt(0)" ::: "memory");
  float rli[16];
#pragma unroll
  for (int r = 0; r < 16; ++r) rli[r] = __builtin_amdgcn_rcpf(li_l[crow(r, hi)]);
  unsigned char* Ow = Ob + (long)(wid * QBLK) * LDO;
#pragma unroll
  for (int r = 0; r < 16; ++r) { int orow = crow(r, hi);
    for (int d0 = 0; d0 < 4; ++d0) { const float v_ = o[d0][r] * rli[r]; Ow[(long)orow * LDO + d0 * 32 + r32] = (unsigned char)__builtin_amdgcn_cvt_pk_fp8_f32(v_, v_, 0u, false); } }
  __syncthreads();
#undef SLOAD
#undef SWRITE
#undef SWAIT
#undef RESC
}
}

#define XB_TMO      128
#define XB_XCNT(j)  (256  + 64 * (j))
#define XB_XSUB(j)  (1280 + 64 * (j))
#define XB_XGEN(j)  (2304 + 64 * (j))
#define XB_TOP      3328
#define XB_TOPGEN   3392
#define XCD_BAR_WORDS 3456
#define XB_SPIN_CAP (1u << 18)
__device__ __forceinline__ unsigned xb_ld(unsigned* p)              { return __hip_atomic_load(p, __ATOMIC_RELAXED, __HIP_MEMORY_SCOPE_AGENT); }
__device__ __forceinline__ unsigned xb_add(unsigned* p, unsigned v) { return __hip_atomic_fetch_add(p, v, __ATOMIC_RELAXED, __HIP_MEMORY_SCOPE_AGENT); }
__device__ __forceinline__ unsigned xb_xcc_id() { return (unsigned)__builtin_amdgcn_s_getreg((3 << 11) | 20) & 0xFu; }
#define XB_SPIN(cond, bar) do { unsigned _sp = 0; while (cond) { __builtin_amdgcn_s_sleep(1); \
    if ((++_sp & 255u) == 0u) { if (xb_ld(&(bar)[XB_TMO])) break; if (_sp > XB_SPIN_CAP) { atomicAdd(&(bar)[XB_TMO], 1u); break; } } } } while (0)
struct XcdBarrier { unsigned* bar; unsigned x; volatile LAS unsigned* st; };
__device__ __forceinline__ XcdBarrier xcd_barrier_post(unsigned* bar, volatile LAS unsigned* st) {
    XcdBarrier b; b.bar = bar; b.x = xb_xcc_id(); b.st = st;
    if (threadIdx.x == 0) (void)xb_add(&bar[XB_XCNT(b.x)], 1u);
    return b;
}
__device__ __forceinline__ void xcd_barrier_complete(unsigned* bar, unsigned x, unsigned& nloc, unsigned& nx) {
    const unsigned G = gridDim.x * gridDim.y * gridDim.z;
    unsigned sum, cnt, mine, sp = 0u;
    for (;;) {
        sum = 0u; cnt = 0u; mine = 0u;
#pragma unroll
        for (unsigned j = 0; j < 16; ++j) { const unsigned c = xb_ld(&bar[XB_XCNT(j)]); sum += c; cnt += (c > 0u) ? 1u : 0u; mine = (j == x) ? c : mine; }
        if (sum == G) break;
        __builtin_amdgcn_s_sleep(1);
        if ((++sp & 255u) == 0u) { if (xb_ld(&bar[XB_TMO])) break; if (sp > XB_SPIN_CAP) { atomicAdd(&bar[XB_TMO], 1u); break; } }
    }
    nloc = mine > 0u ? mine : 1u; nx = cnt > 0u ? cnt : 1u;
}
__device__ __forceinline__ void xcd_barrier(const XcdBarrier& b) {
    asm volatile("s_waitcnt vmcnt(0)" ::: "memory");
    __syncthreads();
    if (threadIdx.x == 0) {
        unsigned* bar = b.bar;
        __builtin_amdgcn_s_waitcnt(0);
        unsigned nloc = b.st[0], nx = b.st[1];
        if (nloc == 0u) { xcd_barrier_complete(bar, b.x, nloc, nx); b.st[0] = nloc; b.st[1] = nx; }
        const unsigned old = xb_add(&bar[XB_XSUB(b.x)], 1u);
        const unsigned gen = old / nloc;
        if (old + 1u == (gen + 1u) * nloc) {
            __builtin_amdgcn_fence(__ATOMIC_RELEASE, "agent");
            asm volatile("s_waitcnt vmcnt(0)" ::: "memory");
            const unsigned og = xb_add(&bar[XB_TOP], 1u);
            const unsigned tg = og / nx;
            if (og + 1u == (tg + 1u) * nx) xb_add(&bar[XB_TOPGEN], 1u);
            else XB_SPIN(xb_ld(&bar[XB_TOPGEN]) == tg, bar);
            __builtin_amdgcn_fence(__ATOMIC_ACQUIRE, "agent");
            xb_add(&bar[XB_XGEN(b.x)], 1u);
            asm volatile("s_waitcnt vmcnt(0)" ::: "memory");
        } else {
            XB_SPIN(xb_ld(&bar[XB_XGEN(b.x)]) == gen, bar);
            __builtin_amdgcn_fence(__ATOMIC_ACQUIRE, "agent");
            asm volatile("s_waitcnt vmcnt(0)" ::: "memory");
        }
    }
    __syncthreads();
}

struct Args {
    const float* in[26];
    float* out; unsigned char* ws;
    int ph_lo, ph_hi, use_bar, pad;
};
enum { I_X = 0, I_P, I_GMIX, I_WIN, I_QN, I_KN, I_CONVW, I_CONVB, I_LWA, I_LBA, I_LWI, I_LBI, I_LAM, I_WABR, I_WLBR, I_WOUT, I_GMOE, I_WR, I_BR, I_WGU, I_BGU, I_WDN, I_BDN, I_GPLE, I_WPG, I_WPP };

struct Frame {
    LAS unsigned char* lds; char* lds_g;
    int tid, lane, wave, G, c;
    const Args* a;
};

template <class Map>
__device__ __forceinline__ void p0_transpose_item(const float* W, int K, int N, bf16* WT, const float* gain, LAS float* scr, int item, int lane, const Map& map) {
    const int nblk = N / 64, kb = item / nblk, nb = item % nblk, k0 = 64 * kb, n0 = 64 * nb;
#pragma unroll 4
    for (int it = 0; it < 16; ++it) { const int kk = 4 * it + (lane >> 4), nn = 4 * (lane & 15);
        f32x4 v = *(const f32x4*)(W + (size_t)(k0 + kk) * N + n0 + nn);
        if (gain) v = v * gain[k0 + kk];
        LAS float* d = scr + kk * 65 + nn; d[0] = v[0]; d[1] = v[1]; d[2] = v[2]; d[3] = v[3]; }
    LDS_WAIT(); asm volatile("" ::: "memory");
    const int c = lane & 7;
#pragma unroll
    for (int j = 0; j < 8; ++j) { const int n = (lane >> 3) + 8 * j; const LAS float* s = scr + (8 * c) * 65 + n;
        u32x4 o; o.x = pk2(s[0 * 65], s[1 * 65]); o.y = pk2(s[2 * 65], s[3 * 65]); o.z = pk2(s[4 * 65], s[5 * 65]); o.w = pk2(s[6 * 65], s[7 * 65]);
        *(u32x4*)(WT + (size_t)map(n0 + n) * K + k0 + 8 * c) = o; }
    LDS_WAIT(); asm volatile("" ::: "memory");
}
struct MapId { __device__ __forceinline__ int operator()(int n) const { return n; } };
struct MapWinF8 { __device__ __forceinline__ int operator()(int n) const { return n < 2560 ? n : n - 1024; } };
struct MapWinBf { __device__ __forceinline__ int operator()(int n) const { return n + 2048; } };
struct MapGU { __device__ __forceinline__ int operator()(int n) const { const int up = n >> 10, j = n & 1023; return 256 * (j >> 7) + 128 * up + (j & 127); } };
template <class Map>
__device__ __forceinline__ void p0_transpose_item_f8(const float* W, int K, int N, unsigned char* WT, const float* gain, LAS float* scr, int item, int lane, const Map& map) {
    const int nblk = N / 64, kb = item / nblk, nb = item % nblk, k0 = 64 * kb, n0 = 64 * nb;
#pragma unroll 4
    for (int it = 0; it < 16; ++it) { const int kk = 4 * it + (lane >> 4), nn = 4 * (lane & 15);
        f32x4 v = *(const f32x4*)(W + (size_t)(k0 + kk) * N + n0 + nn);
        v = v * (gain ? 32.0f * gain[k0 + kk] : 32.0f);
        LAS float* d = scr + kk * 65 + nn; d[0] = v[0]; d[1] = v[1]; d[2] = v[2]; d[3] = v[3]; }
    LDS_WAIT(); asm volatile("" ::: "memory");
    const int c = lane & 7;
#pragma unroll
    for (int j = 0; j < 8; ++j) { const int n = (lane >> 3) + 8 * j; const LAS float* s = scr + (8 * c) * 65 + n;
        u32x2 o = {0u, 0u}; o.x = __builtin_amdgcn_cvt_pk_fp8_f32(s[0 * 65], s[1 * 65], o.x, false); o.x = __builtin_amdgcn_cvt_pk_fp8_f32(s[2 * 65], s[3 * 65], o.x, true);
        o.y = __builtin_amdgcn_cvt_pk_fp8_f32(s[4 * 65], s[5 * 65], o.y, false); o.y = __builtin_amdgcn_cvt_pk_fp8_f32(s[6 * 65], s[7 * 65], o.y, true);
        *(u32x2*)(WT + (size_t)map(n0 + n) * K + k0 + 8 * c) = o; }
    LDS_WAIT(); asm volatile("" ::: "memory");
}

struct XwItem { const float* src; unsigned char* dst; const float* gain; int N, k0, n0, gu; };
__device__ __forceinline__ XwItem xw_item(const Args& A, unsigned char* ws, int it, int lane) {
    XwItem d; int r;
    if (it < NE * 512) { const int e = it >> 9; r = it & 511; d.N = 2048; d.gu = 1; d.gain = A.in[I_GMOE]; d.src = A.in[I_WGU] + (size_t)e * 1024 * 2048; d.dst = ws + WS_WGU + (size_t)e * 2048 * 1024; d.k0 = 64 * (r >> 5); d.n0 = 64 * (r & 31); }
    else { const int q = it - NE * 512, e = q >> 8; r = q & 255; d.N = 1024; d.gu = 0; d.gain = nullptr; d.src = A.in[I_WDN] + (size_t)e * 1024 * 1024; d.dst = ws + WS_WDN + (size_t)e * 1024 * 1024; d.k0 = 64 * (r >> 4); d.n0 = 64 * (r & 15); }
    d.src += (size_t)(d.k0 + (lane >> 4)) * d.N + d.n0 + 4 * (lane & 15);
    return d;
}
#define XW_LOAD(R, d) do { _Pragma("unroll") for (int i_ = 0; i_ < 16; ++i_) R[i_] = *(const f32x4*)((d).src + (size_t)(4 * i_) * (d).N); } while (0)
__device__ __forceinline__ void xw_finish(const f32x4 (&R)[16], const XwItem& d, LAS float* scr, int lane) {
#pragma unroll
    for (int it = 0; it < 16; ++it) { LAS float* p = scr + (4 * it + (lane >> 4)) * 65 + 4 * (lane & 15); p[0] = R[it][0]; p[1] = R[it][1]; p[2] = R[it][2]; p[3] = R[it][3]; }
    LDS_WAIT(); asm volatile("" ::: "memory");
    const int c = lane & 7;
    f32x4 g0 = {32.f, 32.f, 32.f, 32.f}, g1 = g0;
    if (d.gain) { g0 = *(const f32x4*)(d.gain + d.k0 + 8 * c) * 32.0f; g1 = *(const f32x4*)(d.gain + d.k0 + 8 * c + 4) * 32.0f; }
#pragma unroll
    for (int j = 0; j < 8; ++j) { const int n = (lane >> 3) + 8 * j; const LAS float* s = scr + (8 * c) * 65 + n;
        u32x2 o = {0u, 0u}; o.x = __builtin_amdgcn_cvt_pk_fp8_f32(s[0 * 65] * g0[0], s[1 * 65] * g0[1], o.x, false); o.x = __builtin_amdgcn_cvt_pk_fp8_f32(s[2 * 65] * g0[2], s[3 * 65] * g0[3], o.x, true);
        o.y = __builtin_amdgcn_cvt_pk_fp8_f32(s[4 * 65] * g1[0], s[5 * 65] * g1[1], o.y, false); o.y = __builtin_amdgcn_cvt_pk_fp8_f32(s[6 * 65] * g1[2], s[7 * 65] * g1[3], o.y, true);
        const int nn = d.n0 + n; const int row = d.gu ? MapGU()(nn) : nn;
        *(u32x2*)(d.dst + (size_t)row * 1024 + d.k0 + 8 * c) = o; }
    LDS_WAIT(); asm volatile("" ::: "memory");
}
__device__ __forceinline__ void p0_expert_weights(Frame& F) {
    const Args& A = *F.a; unsigned char* ws = A.ws;
    LAS float* scr = (LAS float*)(F.lds + F.wave * 16640);
    const int gw = F.c * 8 + F.wave, NGW = F.G * 8;
    constexpr int NIT = NE * 512 + NE * 256;
    int it = gw; if (it >= NIT) return;
    f32x4 Ra[16], Rb[16]; XwItem da = xw_item(A, ws, it, F.lane), db = da;
    XW_LOAD(Ra, da);
    for (;;) {
        const int i1 = it + NGW; const bool h1 = i1 < NIT; if (h1) { db = xw_item(A, ws, i1, F.lane); XW_LOAD(Rb, db); }
        xw_finish(Ra, da, scr, F.lane);
        if (!h1) break;
        const int i2 = i1 + NGW; const bool h2 = i2 < NIT; if (h2) { da = xw_item(A, ws, i2, F.lane); XW_LOAD(Ra, da); }
        xw_finish(Rb, db, scr, F.lane);
        if (!h2) break;
        it = i2;
    }
}
#undef XW_LOAD

__device__ __forceinline__ void p0_prologue(Frame& F) {
    const Args& A = *F.a; unsigned char* ws = A.ws;
    LAS float* scr = (LAS float*)(F.lds + F.wave * 16640);
    const int gw = F.c * 8 + F.wave, NGW = F.G * 8;
    constexpr int I_IN = 16 * (IN_W / 64);
    constexpr int I_SQ = 16 * 16;
    constexpr int I_PP = 4 * 16;
    constexpr int NITEMS = I_IN + 4 * I_SQ + I_PP;
    p0_expert_weights(F);
    for (int it = gw; it < NITEMS; it += NGW) {
        int r = it;
        if (r < I_IN) { const int nb_ = r % (IN_W / 64);
            if (nb_ < 40 || nb_ >= 56) p0_transpose_item_f8(A.in[I_WIN], 1024, IN_W, ws + WS_WIN, A.in[I_GMIX], scr, r, F.lane, MapWinF8());
            else p0_transpose_item(A.in[I_WIN], 1024, IN_W, (bf16*)(ws + WS_WIN), A.in[I_GMIX], scr, r, F.lane, MapWinBf());
            continue; } r -= I_IN;
        if (r < I_SQ) { p0_transpose_item_f8(A.in[I_WABR], 1024, 1024, ws + WS_WABR, nullptr, scr, r, F.lane, MapId()); continue; } r -= I_SQ;
        if (r < I_SQ) { p0_transpose_item(A.in[I_WLBR], 1024, 1024, (bf16*)(ws + WS_WLBR), nullptr, scr, r, F.lane, MapId()); continue; } r -= I_SQ;
        if (r < I_SQ) { p0_transpose_item_f8(A.in[I_WOUT], 1024, 1024, ws + WS_WOUT, nullptr, scr, r, F.lane, MapId()); continue; } r -= I_SQ;
        if (r < I_SQ) { p0_transpose_item_f8(A.in[I_WPG], 1024, 1024, ws + WS_WPG, A.in[I_GPLE], scr, r, F.lane, MapId()); continue; } r -= I_SQ;
        p0_transpose_item(A.in[I_WPP], 256, 1024, (bf16*)(ws + WS_WPP), nullptr, scr, r, F.lane, MapId());
    }
    for (int it = gw; it < 2 * 32 * 2; it += NGW) { const int hl = it >> 6, ks = (it >> 1) & 31, nt = it & 1; const int e = 16 * nt + (F.lane & 15);
        unsigned w[4];
#pragma unroll
        for (int jj = 0; jj < 4; ++jj) { float v[2];
#pragma unroll
            for (int q = 0; q < 2; ++q) { const int k = 32 * ks + 8 * (F.lane >> 4) + 2 * jj + q; const float x = A.in[I_GMOE][k] * A.in[I_WR][k * NE + e]; const float h = bf2f((unsigned short)f2bf(x)); v[q] = hl ? (x - h) : x; }
            w[jj] = pk2(v[0], v[1]); }
        *(u32x4*)(ws + WS_RW + ((size_t)it * 64 + F.lane) * 16) = (u32x4){w[0], w[1], w[2], w[3]}; }
    {
        for (int m0 = gw; m0 < T; m0 += 2 * NGW) {
            const int m1 = m0 + NGW; const bool has1 = m1 < T;
            const f32x4* xr0 = (const f32x4*)(A.in[I_X] + (size_t)m0 * D_MODEL) + F.lane; const f32x4* xr1 = (const f32x4*)(A.in[I_X] + (size_t)(has1 ? m1 : m0) * D_MODEL) + F.lane;
            f32x4 v0[4], v1[4];
#pragma unroll
            for (int j = 0; j < 4; ++j) { v0[j] = xr0[64 * j]; v1[j] = xr1[64 * j]; }
            const f32x4 pv0 = *((const f32x4*)(A.in[I_P] + (size_t)m0 * PLE) + F.lane), pv1 = *((const f32x4*)(A.in[I_P] + (size_t)(has1 ? m1 : m0) * PLE) + F.lane);
            float s0 = 0.f, s1 = 0.f;
#pragma unroll
            for (int j = 0; j < 4; ++j) { s0 += (v0[j].x * v0[j].x + v0[j].y * v0[j].y) + (v0[j].z * v0[j].z + v0[j].w * v0[j].w); s1 += (v1[j].x * v1[j].x + v1[j].y * v1[j].y) + (v1[j].z * v1[j].z + v1[j].w * v1[j].w); }
            const float r0 = 1.0f / sqrtf(wave_sum(s0) * (1.f / D_MODEL) + EPS), r1 = 1.0f / sqrtf(wave_sum(s1) * (1.f / D_MODEL) + EPS);
            unsigned long long* o0 = (unsigned long long*)((bf16*)(ws + WS_U1) + (size_t)m0 * D_MODEL) + F.lane;
#pragma unroll
            for (int j = 0; j < 4; ++j) o0[64 * j] = (unsigned long long)cvt_pk_bf16(v0[j].x * r0, v0[j].y * r0) | ((unsigned long long)cvt_pk_bf16(v0[j].z * r0, v0[j].w * r0) << 32);
            { unsigned* q0 = (unsigned*)(ws + WS_H1F8 + (size_t)m0 * 1024) + F.lane;
#pragma unroll
              for (int j = 0; j < 4; ++j) { unsigned w8 = 0u; w8 = __builtin_amdgcn_cvt_pk_fp8_f32(v0[j].x * r0, v0[j].y * r0, w8, false); w8 = __builtin_amdgcn_cvt_pk_fp8_f32(v0[j].z * r0, v0[j].w * r0, w8, true); q0[64 * j] = w8; } }
            *((unsigned long long*)((bf16*)(ws + WS_PB) + (size_t)m0 * PLE) + F.lane) = (unsigned long long)cvt_pk_bf16(pv0.x, pv0.y) | ((unsigned long long)cvt_pk_bf16(pv0.z, pv0.w) << 32);
            if (has1) { unsigned long long* o1 = (unsigned long long*)((bf16*)(ws + WS_U1) + (size_t)m1 * D_MODEL) + F.lane;
#pragma unroll
                for (int j = 0; j < 4; ++j) o1[64 * j] = (unsigned long long)cvt_pk_bf16(v1[j].x * r1, v1[j].y * r1) | ((unsigned long long)cvt_pk_bf16(v1[j].z * r1, v1[j].w * r1) << 32);
                { unsigned* q1 = (unsigned*)(ws + WS_H1F8 + (size_t)m1 * 1024) + F.lane;
#pragma unroll
                  for (int j = 0; j < 4; ++j) { unsigned w8 = 0u; w8 = __builtin_amdgcn_cvt_pk_fp8_f32(v1[j].x * r1, v1[j].y * r1, w8, false); w8 = __builtin_amdgcn_cvt_pk_fp8_f32(v1[j].z * r1, v1[j].w * r1, w8, true); q1[64 * j] = w8; } }
                *((unsigned long long*)((bf16*)(ws + WS_PB) + (size_t)m1 * PLE) + F.lane) = (unsigned long long)cvt_pk_bf16(pv1.x, pv1.y) | ((unsigned long long)cvt_pk_bf16(pv1.z, pv1.w) << 32); }
        }
    }
}

__device__ __forceinline__ void p2_qknorm_rope(Frame& F) {
    const Args& A = *F.a; unsigned char* ws = A.ws;
    LAS float* tab = (LAS float*)F.lds;
    for (int i = F.tid; i < 64 * 32; i += 512) { const int id = i >> 5, j = i & 31; const float inv = powf(10000.0f, -(float)(2 * j) / 64.0f); float s, c; sincosf((float)id * inv, &s, &c); tab[2 * i] = c; tab[2 * i + 1] = s; }
    __syncthreads();
    const int sub = F.lane >> 3, li = F.lane & 7;
    const long nitems = (long)T * 2;
    const float* gn = A.in[I_KN];
    f32x4 gv[4];
#pragma unroll
    for (int q = 0; q < 4; ++q) gv[q] = *(const f32x4*)(gn + 32 * q + 4 * li);
    for (long it0 = ((long)F.c * 8 + F.wave) * 8; it0 < nitems; it0 += (long)F.G * 64 * 4) {
        u32x2 wv[4][4]; bool ok[4];
#pragma unroll
        for (int u = 0; u < 4; ++u) { const long it = it0 + (long)u * F.G * 64 + sub; ok[u] = it < nitems; const long itc = ok[u] ? it : (long)sub; const int tok = (int)(itc >> 1), kh = (int)(itc & 1);
            const bf16* p = (const bf16*)(ws + WS_K) + (size_t)tok * 256 + kh * 128;
#pragma unroll
            for (int q = 0; q < 4; ++q) wv[u][q] = *(const u32x2*)(p + 32 * q + 4 * li); }
#pragma unroll
        for (int u = 0; u < 4; ++u) { const long it = it0 + (long)u * F.G * 64 + sub; const int tok = (int)(it >> 1), kh = (int)(it & 1);
            bf16* p = (bf16*)(ws + WS_K) + (size_t)tok * 256 + kh * 128;
            float v[4][4]; float ss = 0.f;
#pragma unroll
            for (int q = 0; q < 4; ++q) { const u32x2 w = wv[u][q]; v[q][0] = bflo(w.x); v[q][1] = bfhi(w.x); v[q][2] = bflo(w.y); v[q][3] = bfhi(w.y);
                ss += (v[q][0] * v[q][0] + v[q][1] * v[q][1]) + (v[q][2] * v[q][2] + v[q][3] * v[q][3]); }
            ss += __shfl_xor(ss, 1); ss += __shfl_xor(ss, 2); ss += __shfl_xor(ss, 4);
            const float rstd = 1.0f / sqrtf(ss * (1.f / 128.f) + EPS);
#pragma unroll
            for (int q = 0; q < 4; ++q) {
#pragma unroll
                for (int e = 0; e < 4; ++e) v[q][e] = v[q][e] * rstd * gv[q][e]; }
            const int s = tok & (SEQ - 1), rid = s >> 6, cid = s & 63;
            float o[4][4];
#pragma unroll
            for (int e = 0; e < 4; ++e) { const int j = 4 * li + e;
                const float cr = tab[2 * (rid * 32 + j)], sr = tab[2 * (rid * 32 + j) + 1], cc = tab[2 * (cid * 32 + j)], sc = tab[2 * (cid * 32 + j) + 1];
                o[0][e] = v[0][e] * cr - v[1][e] * sr; o[1][e] = v[1][e] * cr + v[0][e] * sr;
                o[2][e] = v[2][e] * cc - v[3][e] * sc; o[3][e] = v[3][e] * cc + v[2][e] * sc; }
            if (ok[u]) {
#pragma unroll
                for (int q = 0; q < 4; ++q) { u32x2 w; w.x = pk2(o[q][0], o[q][1]); w.y = pk2(o[q][2], o[q][3]); *(u32x2*)(p + 32 * q + 4 * li) = w; } } }
    }
    __syncthreads();
}

__device__ __forceinline__ void p3_lru_unit(Frame& F, int unit) {
    const Args& A = *F.a; unsigned char* ws = A.ws;
    const int b = unit >> 4, nb = (unit >> 1) & 7, hb = unit & 1;
    LAS unsigned char* CA = F.lds; LAS float* CF = (LAS float*)(F.lds + 32768); LAS float* HT = (LAS float*)F.lds;
    LAS float* EX = (LAS float*)(F.lds + 65536); LAS float* CW = (LAS float*)(F.lds + 67584); LAS unsigned char* WB = F.lds + 70656;
    int tid_ = threadIdx.x; asm volatile("" : "+v"(tid_));
    const int tid = tid_, w = F.wave, lane = tid & 63, r32 = lane & 31, hi = lane >> 5;
    const int d = w >> 2, mt = (w >> 1) & 1, cb = w & 1;
    const int chl = 32 * cb + r32;
    const int chb = 64 * hb + chl;
    const int chg = nb * 128 + chb;
#define LBAR() do { asm volatile("s_waitcnt lgkmcnt(0)" ::: "memory"); __builtin_amdgcn_s_barrier(); asm volatile("" ::: "memory"); } while (0)
    { const int i1 = tid + 512; const bool h1_ = i1 < 5 * 128;
      const float c0 = A.in[I_CONVW][(tid >> 7) * LRU_W + nb * 128 + (tid & 127)];
      const float c1 = h1_ ? A.in[I_CONVB][nb * 128 + (i1 & 127)] : 0.f;
      CW[tid] = c0; if (h1_) CW[i1] = c1; }
    {
        f32x4 wv_[16];
#pragma unroll
        for (int it = 0; it < 16; ++it) { const int i = tid + it * 512; const int e4 = (i & 15) * 4, k = (i >> 4) & 127, gsel = (i >> 11) & 1, dd = i >> 12;
            wv_[it] = *(const f32x4*)((gsel ? A.in[I_LWI] : A.in[I_LWA]) + ((size_t)(dd * 8 + nb) * 128 + k) * 128 + 64 * hb + e4); }
#pragma unroll
        for (int it = 0; it < 16; ++it) { const int i = tid + it * 512; const int e4 = (i & 15) * 4, k = (i >> 4) & 127, gsel = (i >> 11) & 1, dd = i >> 12; const f32x4 v = wv_[it];
#pragma unroll
            for (int q = 0; q < 4; ++q) *(LAS unsigned short*)(WB + (dd * 2 + gsel) * 16384 + KSWZ(e4 + q, 2 * k)) = (unsigned short)f2bf(v[q]); } }
    const float nba = -1.4426950408889634f * A.in[I_LBA][d * LRU_W + chg], nbi = -1.4426950408889634f * A.in[I_LBI][d * LRU_W + chg];
    float k8; { const float lam = A.in[I_LAM][d * LRU_W + chg]; const float z = -lam; const float sp = (z > 20.f) ? z : log1pf(expf(z)); k8 = -8.0f * sp * 1.4426950408889634f; }
    float carry = 0.f;
    const bf16* XR = (const bf16*)(ws + WS_XR) + (size_t)b * SEQ * 1024 + nb * 128;
    bf16* XG = (bf16*)(ws + WS_XG) + (size_t)b * SEQ * 1024 + nb * 128 + hb * 64;
    bf16* HTMP = (bf16*)(ws + WS_U1) + (size_t)b * SEQ * 1024 + nb * 128 + hb * 64;
    const int sg = tid & 15, sr4 = (tid >> 4) & 15, sdd = tid >> 8;
    const int og = tid & 3, orow = (tid >> 2) & 63, odd = tid >> 8;
    u32x4 PF[7];
    const __amdgpu_buffer_rsrc_t xr_rsrc = __builtin_amdgcn_make_buffer_rsrc((void*)((const bf16*)(ws + WS_XR) + (size_t)b * SEQ * 1024), 0, SEQ * 2048, 0x00020000);
#define LRU_PF(jn) do { const int t0_ = 64 * (sdd ? 31 - (jn) : (jn)) + 4 * sr4 - 2; _Pragma("unroll") for (int i_ = 0; i_ < 7; ++i_) \
        PF[i_] = __builtin_bit_cast(u32x4, __builtin_amdgcn_raw_buffer_load_b128(xr_rsrc, (unsigned)((t0_ + i_) * 2048 + (nb * 128 + 8 * sg) * 2), 0, 0)); } while (0)
    LRU_PF(0);
    __syncthreads();
    for (int j = 0; j < 32; ++j) {
        { f32x2 wv[4][4], bvv[4];
#pragma unroll
          for (int k = 0; k < 4; ++k) { const f32x4 w0 = *(const LAS f32x4*)(CW + k * 128 + 8 * sg), w1 = *(const LAS f32x4*)(CW + k * 128 + 8 * sg + 4);
              wv[k][0] = (f32x2){w0[0], w0[1]}; wv[k][1] = (f32x2){w0[2], w0[3]}; wv[k][2] = (f32x2){w1[0], w1[1]}; wv[k][3] = (f32x2){w1[2], w1[3]}; }
          { const f32x4 b0 = *(const LAS f32x4*)(CW + 4 * 128 + 8 * sg), b1 = *(const LAS f32x4*)(CW + 4 * 128 + 8 * sg + 4);
            bvv[0] = (f32x2){b0[0], b0[1]}; bvv[1] = (f32x2){b0[2], b0[3]}; bvv[2] = (f32x2){b1[0], b1[1]}; bvv[3] = (f32x2){b1[2], b1[3]}; }
#pragma unroll
          for (int rr = 0; rr < 4; ++rr) { f32x2 c[4] = {bvv[0], bvv[1], bvv[2], bvv[3]};
#pragma unroll
            for (int k = 0; k < 4; ++k) { const u32x4 xv = PF[rr + k];
                c[0] = wv[k][0] * (f32x2){bflo(xv.x), bfhi(xv.x)} + c[0]; c[1] = wv[k][1] * (f32x2){bflo(xv.y), bfhi(xv.y)} + c[1];
                c[2] = wv[k][2] * (f32x2){bflo(xv.z), bfhi(xv.z)} + c[2]; c[3] = wv[k][3] * (f32x2){bflo(xv.w), bfhi(xv.w)} + c[3]; }
            const int r = 4 * sr4 + rr;
            u32x4 pw; pw.x = cvt_pk_bf16(c[0].x, c[0].y); pw.y = cvt_pk_bf16(c[1].x, c[1].y); pw.z = cvt_pk_bf16(c[2].x, c[2].y); pw.w = cvt_pk_bf16(c[3].x, c[3].y);
            *(LAS u32x4*)(CA + sdd * 16384 + KSWZ(r, 16 * sg)) = pw;
            if ((sg >> 3) == hb) { LAS float* cf = CF + (sdd * 64 + r) * 64 + 8 * (sg & 7); *(LAS f32x4*)cf = (f32x4){c[0].x, c[0].y, c[1].x, c[1].y}; *(LAS f32x4*)(cf + 4) = (f32x4){c[2].x, c[2].y, c[3].x, c[3].y}; } } }
        if (j + 1 < 32) LRU_PF(j + 1);
        LBAR();
        f32x16 ga = {}, gi = {};
#pragma unroll
        for (int ks = 0; ks < 8; ++ks) { const bf16x8 af = *(const LAS bf16x8*)(CA + d * 16384 + KSWZ(32 * mt + r32, (ks * 16 + hi * 8) * 2));
            const bf16x8 bfa = *(const LAS bf16x8*)(WB + (d * 2 + 0) * 16384 + KSWZ(chl, (ks * 16 + hi * 8) * 2)), bfi = *(const LAS bf16x8*)(WB + (d * 2 + 1) * 16384 + KSWZ(chl, (ks * 16 + hi * 8) * 2));
            ga = __builtin_amdgcn_mfma_f32_32x32x16_bf16(af, bfa, ga, 0, 0, 0); gi = __builtin_amdgcn_mfma_f32_32x32x16_bf16(af, bfi, gi, 0, 0, 0); }
        float av[16], bv[16];
#pragma unroll
        for (int r = 0; r < 16; ++r) { const int row = 32 * mt + attn::crow(r, hi);
            const float ra = __builtin_amdgcn_rcpf(1.0f + __builtin_amdgcn_exp2f(__builtin_fmaf(ga[r], -1.4426950408889634f, nba))), ii = __builtin_amdgcn_rcpf(1.0f + __builtin_amdgcn_exp2f(__builtin_fmaf(gi[r], -1.4426950408889634f, nbi)));
            const float a = __builtin_amdgcn_exp2f(k8 * ra); const float mult = __builtin_amdgcn_sqrtf(fmaxf(1.0f - a * a, 0.f));
            av[r] = a; bv[r] = mult * ii * CF[(d * 64 + row) * 64 + chl]; }
        float A4[4], H4[4];
#pragma unroll
        for (int q = 0; q < 4; ++q) { float hh = 0.f, aa = 1.f;
            if (d == 0) {
#pragma unroll
                for (int i = 0; i < 4; ++i) { hh = av[4 * q + i] * hh + bv[4 * q + i]; aa *= av[4 * q + i]; } }
            else {
#pragma unroll
                for (int i = 3; i >= 0; --i) { hh = av[4 * q + i] * hh + bv[4 * q + i]; aa *= av[4 * q + i]; } }
            A4[q] = aa; H4[q] = hh; }
        float Ag[8], Hg[8];
#pragma unroll
        for (int q = 0; q < 4; ++q) { auto ra = __builtin_amdgcn_permlane32_swap(__float_as_uint(A4[q]), __float_as_uint(A4[q]), false, false); auto rh = __builtin_amdgcn_permlane32_swap(__float_as_uint(H4[q]), __float_as_uint(H4[q]), false, false);
            Ag[2 * q] = __uint_as_float(ra[0]); Ag[2 * q + 1] = __uint_as_float(ra[1]); Hg[2 * q] = __uint_as_float(rh[0]); Hg[2 * q + 1] = __uint_as_float(rh[1]); }
        float Ac[4], Hc[4];
        float At = 1.f, Ht = 0.f;
        if (d == 0) {
#pragma unroll
            for (int g = 0; g < 8; ++g) { if ((g & 1) == hi) { Ac[g >> 1] = At; Hc[g >> 1] = Ht; } Ht = Ag[g] * Ht + Hg[g]; At = Ag[g] * At; } }
        else {
#pragma unroll
            for (int g = 7; g >= 0; --g) { if ((g & 1) == hi) { Ac[g >> 1] = At; Hc[g >> 1] = Ht; } Ht = Ag[g] * Ht + Hg[g]; At = Ag[g] * At; } }
        if (hi == 0) { LAS float* ex = EX + ((d * 2 + mt) * 64 + chl) * 2; ex[0] = At; ex[1] = Ht; }
        u32x4 oph0 = {0u, 0u, 0u, 0u}, oph1 = {0u, 0u, 0u, 0u}, opx0 = {0u, 0u, 0u, 0u}, opx1 = {0u, 0u, 0u, 0u};
        const size_t ooff = (size_t)(64 * (odd ? 31 - j : j) + orow) * 1024 + 16 * og;
        if (j >= 16) { oph0 = *(const u32x4*)(HTMP + ooff); oph1 = *(const u32x4*)(HTMP + ooff + 8); opx0 = *(const u32x4*)(XG + ooff); opx1 = *(const u32x4*)(XG + ooff + 8); }
        LBAR();
        { const LAS float* e0 = EX + ((d * 2 + 0) * 64 + chl) * 2; const LAS float* e1 = EX + ((d * 2 + 1) * 64 + chl) * 2;
          const float A0 = e0[0], H0 = e0[1], A1 = e1[0], H1 = e1[1]; float hin;
          if (d == 0) { const float h1in = A0 * carry + H0; hin = mt ? h1in : carry; carry = A1 * h1in + H1; }
          else { const float h0in = A1 * carry + H1; hin = mt ? carry : h0in; carry = A0 * h0in + H0; }
#pragma unroll
          for (int q = 0; q < 4; ++q) { float hh = Ac[q] * hin + Hc[q];
              if (d == 0) {
#pragma unroll
                  for (int i = 0; i < 4; ++i) { hh = av[4 * q + i] * hh + bv[4 * q + i]; HT[(d * 64 + 32 * mt + attn::crow(4 * q + i, hi)) * 64 + chl] = hh; } }
              else {
#pragma unroll
                  for (int i = 3; i >= 0; --i) { hh = av[4 * q + i] * hh + bv[4 * q + i]; HT[(d * 64 + 32 * mt + attn::crow(4 * q + i, hi)) * 64 + chl] = hh; } } } }
        LBAR();
        { const LAS float* hp = HT + (odd * 64 + orow) * 64 + 16 * og; const f32x4 h0 = *(const LAS f32x4*)hp, h1 = *(const LAS f32x4*)(hp + 4), h2 = *(const LAS f32x4*)(hp + 8), h3 = *(const LAS f32x4*)(hp + 12);
          if (j < 16) { u32x4 o0, o1; o0.x = cvt_pk_bf16(h0[0], h0[1]); o0.y = cvt_pk_bf16(h0[2], h0[3]); o0.z = cvt_pk_bf16(h1[0], h1[1]); o0.w = cvt_pk_bf16(h1[2], h1[3]); o1.x = cvt_pk_bf16(h2[0], h2[1]); o1.y = cvt_pk_bf16(h2[2], h2[3]); o1.z = cvt_pk_bf16(h3[0], h3[1]); o1.w = cvt_pk_bf16(h3[2], h3[3]);
              *(u32x4*)(HTMP + ooff) = o0; *(u32x4*)(HTMP + ooff + 8) = o1; }
          else { u32x4 o0, o1;
#define LRU_R2(hv, i0, oh, ox) cvt_pk_bf16((hv[i0] + bflo(oh)) * bflo(ox), (hv[i0 + 1] + bfhi(oh)) * bfhi(ox))
              o0.x = LRU_R2(h0, 0, oph0.x, opx0.x); o0.y = LRU_R2(h0, 2, oph0.y, opx0.y); o0.z = LRU_R2(h1, 0, oph0.z, opx0.z); o0.w = LRU_R2(h1, 2, oph0.w, opx0.w);
              o1.x = LRU_R2(h2, 0, oph1.x, opx1.x); o1.y = LRU_R2(h2, 2, oph1.y, opx1.y); o1.z = LRU_R2(h3, 0, oph1.z, opx1.z); o1.w = LRU_R2(h3, 2, oph1.w, opx1.w);
#undef LRU_R2
              *(u32x4*)(XG + ooff) = o0; *(u32x4*)(XG + ooff + 8) = o1; } }
        if (j == 15) { VM_WAIT(); }
        LBAR();
    }
#undef LRU_PF
#undef LBAR
}

__device__ __forceinline__ void p6_router(Frame& F) {
    const Args& A = *F.a; unsigned char* ws = A.ws;
    LAS float* LG = (LAS float*)F.lds;
    LAS int* LC = (LAS int*)(F.lds + 32768);
    LAS int* LB = (LAS int*)(F.lds + 32768 + 256);
    const bf16* H1 = (const bf16*)(ws + WS_H1);
    const int lane = F.lane, w = F.wave, l15 = lane & 15, l4 = lane >> 4;
    for (int grp = F.c; grp < T / 128; grp += F.G) {
        if (F.tid < 32) LC[F.tid] = 0;
        __syncthreads();
        const int tb = grp * 128 + w * 16;
        const bf16* hrow = H1 + (size_t)(tb + l15) * 1024 + 8 * l4;
        f32x4 acc0 = {0.f, 0.f, 0.f, 0.f}, acc1 = {0.f, 0.f, 0.f, 0.f}; float ss = 0.f;
        unsigned char* u8 = ws + WS_H1F8 + (size_t)(tb + l15) * 1024 + 8 * l4;
#pragma unroll 1
        for (int kc = 0; kc < 32; kc += 8) {
            u32x4 xa[8];
#pragma unroll
            for (int q = 0; q < 8; ++q) xa[q] = *(const u32x4*)(hrow + 32 * (kc + q));
#pragma unroll
            for (int q = 0; q < 8; ++q) { const int ks = kc + q; const u32x4 hx = xa[q];
            const float x0 = bflo(hx.x), x1 = bfhi(hx.x), x2 = bflo(hx.y), x3 = bfhi(hx.y), x4 = bflo(hx.z), x5 = bfhi(hx.z), x6 = bflo(hx.w), x7 = bfhi(hx.w);
            { u32x2 w8 = {0u, 0u};
              w8.x = __builtin_amdgcn_cvt_pk_fp8_f32(x0, x1, w8.x, false); w8.x = __builtin_amdgcn_cvt_pk_fp8_f32(x2, x3, w8.x, true);
              w8.y = __builtin_amdgcn_cvt_pk_fp8_f32(x4, x5, w8.y, false); w8.y = __builtin_amdgcn_cvt_pk_fp8_f32(x6, x7, w8.y, true);
              *(u32x2*)(u8 + 32 * ks) = w8; }
            ss = __builtin_fmaf(x0, x0, ss); ss = __builtin_fmaf(x1, x1, ss); ss = __builtin_fmaf(x2, x2, ss); ss = __builtin_fmaf(x3, x3, ss);
            ss = __builtin_fmaf(x4, x4, ss); ss = __builtin_fmaf(x5, x5, ss); ss = __builtin_fmaf(x6, x6, ss); ss = __builtin_fmaf(x7, x7, ss);
            u32x4 uh = hx; const bf16x8 ah = *reinterpret_cast<bf16x8*>(&uh);
            const unsigned char* rw = ws + WS_RW + ((size_t)(ks * 2) * 64 + lane) * 16;
            const bf16x8 bh0 = *(const bf16x8*)(rw), bh1 = *(const bf16x8*)(rw + 1024), bl0 = *(const bf16x8*)(rw + 65536), bl1 = *(const bf16x8*)(rw + 65536 + 1024);
            acc0 = __builtin_amdgcn_mfma_f32_16x16x32_bf16(ah, bh0, acc0, 0, 0, 0); acc0 = __builtin_amdgcn_mfma_f32_16x16x32_bf16(ah, bl0, acc0, 0, 0, 0);
            acc1 = __builtin_amdgcn_mfma_f32_16x16x32_bf16(ah, bh1, acc1, 0, 0, 0); acc1 = __builtin_amdgcn_mfma_f32_16x16x32_bf16(ah, bl1, acc1, 0, 0, 0); } }
        ss += __shfl_xor(ss, 16); ss += __shfl_xor(ss, 32);
        const float rstd = 1.0f / sqrtf(ss * (1.f / 1024.f) + EPS);
        if (l4 == 0) ((float*)(ws + WS_RSTD1))[tb + l15] = rstd;
        LAS float* lg = LG + w * (16 * 33);
#pragma unroll
        for (int r = 0; r < 4; ++r) { lg[(4 * l4 + r) * 33 + l15] = acc0[r]; lg[(4 * l4 + r) * 33 + 16 + l15] = acc1[r]; }
        if (l4 == 0) lg[l15 * 33 + 32] = rstd;
        LDS_WAIT(); asm volatile("" ::: "memory");
        int ek[4] = {0, 0, 0, 0}, lp[4] = {0, 0, 0, 0}; float gk[4] = {0.f, 0.f, 0.f, 0.f};
        if (lane < 16) { float v[32]; const float rsd = lg[lane * 33 + 32];
#pragma unroll
            for (int e = 0; e < 32; ++e) v[e] = lg[lane * 33 + e] * rsd + A.in[I_BR][e];
            float tv[4];
#pragma unroll
            for (int k = 0; k < 4; ++k) { float best = -3.0e38f; int bi_ = 0;
#pragma unroll
                for (int e = 0; e < 32; ++e) { const bool gt = v[e] > best; best = gt ? v[e] : best; bi_ = gt ? e : bi_; }
                tv[k] = best; ek[k] = bi_;
#pragma unroll
                for (int e = 0; e < 32; ++e) v[e] = (e == bi_) ? -3.0e38f : v[e]; }
            float es[4], sum = 0.f;
#pragma unroll
            for (int k = 0; k < 4; ++k) { es[k] = __expf(tv[k] - tv[0]); sum += es[k]; }
            const float inv = 1.0f / sum;
#pragma unroll
            for (int k = 0; k < 4; ++k) { gk[k] = es[k] * inv; lp[k] = __hip_atomic_fetch_add(&LC[ek[k]], 1, __ATOMIC_RELAXED, __HIP_MEMORY_SCOPE_WORKGROUP); } }
        __syncthreads();
        if (F.tid < 32) LB[F.tid] = (int)__hip_atomic_fetch_add((unsigned*)(ws + WS_CTL) + CW_CNT + F.tid, (unsigned)LC[F.tid], RLX_AGENT);
        __syncthreads();
        if (lane < 16) { const int tok = tb + lane;
#pragma unroll
            for (int k = 0; k < 4; ++k) { const int pos = LB[ek[k]] + lp[k]; ((unsigned*)(ws + WS_EPOS))[tok * 4 + k] = ((unsigned)ek[k] << 20) | (unsigned)pos; ((int*)(ws + WS_LIST))[(size_t)ek[k] * LIST_CAP + pos] = tok * 4 + k; ((float*)(ws + WS_GATES))[tok * 4 + k] = gk[k]; } }
        __syncthreads();
    }
}

__device__ __forceinline__ int moe_tables(Frame& F, LAS int* TAB) {
    unsigned* cnt = (unsigned*)(F.a->ws + WS_CTL) + CW_CNT;
    __syncthreads();
    if (F.tid < 64) {
        const int e = F.lane; const int c = (e < NE) ? (int)__hip_atomic_load(cnt + (e & (NE - 1)), RLX_AGENT) : 0; const int nt = (c + 255) >> 8;
        int pre = nt;
#pragma unroll
        for (int o = 1; o < 32; o <<= 1) { const int v = __shfl_up(pre, o); if (e >= o) pre += v; }
        const int start = pre - nt;
        if (e < NE) { TAB[1 + e] = start; TAB[33 + e] = c; for (int i = 0; i < nt; ++i) TAB[96 + start + i] = e; }
        if (e == NE - 1) TAB[0] = pre; }
    __syncthreads();
    return __builtin_amdgcn_readfirstlane(TAB[0]);
}

template <class Sched>
__device__ __forceinline__ void moe_prepare(Frame& F, const Sched& S, LAS int* TAB, LAS int* GMAP) {
    const Args& A = *F.a; unsigned char* ws = A.ws;
    const int* list = (const int*)(ws + WS_LIST); const float* gates = (const float*)(ws + WS_GATES);
    u32x2* smeta = (u32x2*)(ws + WS_STOK);
    LAS int* UPM = TAB + 700;
    int nu = 0;
    if (F.tid == 0) { pg8::Unit u; int i = 0; for (; i < 20 && S.next(i, u); ++i) UPM[i] = u.pm; UPM[20] = i; }
    __syncthreads();
    nu = __builtin_amdgcn_readfirstlane(UPM[20]);
    constexpr int NIT = 10;
    int ent[NIT]; int slot[NIT];
#pragma unroll
    for (int k = 0; k < NIT; ++k) { const int item = k * 512 + F.tid, ui = item >> 8, r = item & 255; ent[k] = -2; slot[k] = 0;
        if (ui < nu) { const int pm = UPM[ui], e = TAB[96 + pm], idx = (pm - TAB[1 + e]) * 256 + r; slot[k] = pm * 256 + r; ent[k] = (idx < TAB[33 + e]) ? list[(size_t)e * LIST_CAP + idx] : -1; } }
    float gt[NIT], rs_[NIT]; const float* rstd1 = (const float*)(ws + WS_RSTD1); float* srs = (float*)(ws + WS_SGATE);
#pragma unroll
    for (int k = 0; k < NIT; ++k) { gt[k] = 0.f; rs_[k] = 1.f; if (ent[k] >= 0) { gt[k] = gates[ent[k]]; rs_[k] = rstd1[ent[k] >> 2]; } }
#pragma unroll
    for (int k = 0; k < NIT; ++k) if (ent[k] > -2) { const int item = k * 512 + F.tid; GMAP[item] = ent[k] >= 0 ? (ent[k] >> 2) : 0; smeta[slot[k]] = (u32x2){(unsigned)ent[k], __float_as_uint(gt[k])}; srs[slot[k]] = rs_[k]; }
    VM_WAIT();
    __syncthreads();
}

__device__ __forceinline__ void p10_combine(Frame& F, LAS int* TAB) {
    const Args& A = *F.a; unsigned char* ws = A.ws;
    (void)moe_tables(F, TAB);
    const u32x4* EP = (const u32x4*)(ws + WS_EPOS);
    const bf16* H1 = (const bf16*)(ws + WS_H1); const unsigned char* Y = ws + WS_YK; unsigned char* H2B = ws + WS_H1B; bf16* H2H = (bf16*)(ws + WS_H2H); float* rstd2 = (float*)(ws + WS_RSTD2);
    u32x4 epn[2];
    { const int m0 = F.c * 8 + F.wave, m1 = m0 + F.G * 8; epn[0] = EP[m0 < T ? m0 : 0]; epn[1] = EP[m1 < T ? m1 : 0]; }
    for (int m0 = F.c * 8 + F.wave; m0 < T; m0 += F.G * 16) {
        const int m1 = m0 + F.G * 8; const bool has1 = m1 < T;
        const u32x4 epc[2] = {epn[0], epn[1]};
        { const int n0 = m0 + F.G * 16, n1 = n0 + F.G * 8; epn[0] = EP[n0 < T ? n0 : 0]; epn[1] = EP[n1 < T ? n1 : 0]; }
        u32x2 hw[2][4]; unsigned yv[2][4][4];
#pragma unroll
        for (int r = 0; r < 2; ++r) { const int m = r ? (has1 ? m1 : m0) : m0; const u32x4 ep = (r && !has1) ? epc[0] : epc[r];
            size_t yo[4];
#pragma unroll
            for (int k = 0; k < 4; ++k) { const unsigned w_ = __builtin_amdgcn_readfirstlane(ep[k]); yo[k] = ((size_t)TAB[1 + (w_ >> 20)] * 256 + (w_ & 0xFFFFFu)) * 1024; }
#pragma unroll
            for (int j = 0; j < 4; ++j) { const int col = 256 * j + 4 * F.lane; hw[r][j] = *(const u32x2*)(H1 + (size_t)m * 1024 + col);
#pragma unroll
                for (int k = 0; k < 4; ++k) yv[r][j][k] = (k < NOMOE_K) ? *(const unsigned*)(Y + yo[k] + col) : 0u; } }
#pragma unroll
        for (int r = 0; r < 2; ++r) { const int m = r ? m1 : m0; if (r && !has1) break;
            float ss = 0.f;
#pragma unroll
            for (int j = 0; j < 4; ++j) { const int col = 256 * j + 4 * F.lane; const u32x2 hw_ = hw[r][j]; f32x4 h = {bflo(hw_.x), bfhi(hw_.x), bflo(hw_.y), bfhi(hw_.y)};
#pragma unroll
                for (int k = 0; k < NOMOE_K; ++k) { const unsigned y = yv[r][j][k];
                    const f32x2 lo = __builtin_amdgcn_cvt_pk_f32_fp8(y, false), hi2 = __builtin_amdgcn_cvt_pk_f32_fp8(y, true);
                    h[0] += lo[0] * 0.0625f; h[1] += lo[1] * 0.0625f; h[2] += hi2[0] * 0.0625f; h[3] += hi2[1] * 0.0625f; }
                ss += (h[0] * h[0] + h[1] * h[1]) + (h[2] * h[2] + h[3] * h[3]);
                u32x2 hb; hb.x = cvt_pk_bf16(h[0], h[1]); hb.y = cvt_pk_bf16(h[2], h[3]); *(u32x2*)(H2H + (size_t)m * 1024 + col) = hb; unsigned wv = 0u; wv = __builtin_amdgcn_cvt_pk_fp8_f32(h[0], h[1], wv, false); wv = __builtin_amdgcn_cvt_pk_fp8_f32(h[2], h[3], wv, true); *(unsigned*)(H2B + (size_t)m * 1024 + col) = wv; }
            ss = wave_sum(ss);
            if (F.lane == 0) rstd2[m] = 1.0f / sqrtf(ss * (1.f / 1024.f) + EPS); }
    }
}

constexpr int NPHASE = 11;
__global__ void __launch_bounds__(512, 2) mk_fwd(Args args) {
    extern __shared__ __attribute__((aligned(16))) unsigned char lds[];
    Frame F; F.lds = (LAS unsigned char*)lds; F.lds_g = (char*)lds; F.tid = threadIdx.x; F.lane = F.tid & 63; F.wave = __builtin_amdgcn_readfirstlane(F.tid >> 6); F.G = gridDim.x; F.c = blockIdx.x; F.a = &args;
    unsigned char* ws = args.ws;
    volatile LAS unsigned* LCTL = (volatile LAS unsigned*)(F.lds + LDS_CTL_OFF);
    if (F.tid < 64) LCTL[F.tid] = 0u;
    __syncthreads();
    XcdBarrier bar; bar.bar = (unsigned*)(ws + WS_CTL) + CW_BAR; bar.x = 0; bar.st = nullptr;
    if (args.use_bar) bar = xcd_barrier_post((unsigned*)(ws + WS_CTL) + CW_BAR, LCTL);
    const int lo = args.ph_lo, hi = args.ph_hi;
#ifdef PHASE_MASK
#define IN(k) (((PHASE_MASK >> (k)) & 1) && lo <= (k) && (k) < hi)
#else
#define IN(k) (lo <= (k) && (k) < hi)
#endif
#ifdef STAMP_SEL
#define STAMP(k) do { if (blockIdx.x == 0 && F.tid == 0) { const unsigned long long t_ = __builtin_amdgcn_s_memrealtime(); LCTL[16 + 2 * (k)] = (unsigned)t_; LCTL[17 + 2 * (k)] = (unsigned)(t_ >> 32); } } while (0)
#else
#define STAMP(k) do { } while (0)
#endif
#define SEAM(k) do { if (IN(k) && IN((k) + 1)) xcd_barrier(bar); STAMP((k) + 1); } while (0)
    LAS int* TAB = (LAS int*)(F.lds + LDS_TAB_OFF);

    STAMP(0);
    if (IN(0)) { p0_prologue(F); } SEAM(0);

    if (IN(1)) {
        { pg8::Gemm g{ws + WS_H1F8, ws + WS_WIN, T, 4608, 1024, 1024}; pg8::StaticOrder S; S.init(g, F.G, F.c);
          pg8::EpiInProj E{(bf16*)(ws + WS_Q), (bf16*)(ws + WS_K), (bf16*)(ws + WS_V), (bf16*)(ws + WS_XR), (bf16*)(ws + WS_XG), (bf16*)(ws + WS_GA), (bf16*)(ws + WS_GR), 0};
          pg8::gemm_phase<pg8::EpiInProj, pg8::StaticOrder, true, true>(F.lds, g, S, E); }
        { pg8::Gemm g{(const bf16*)(ws + WS_U1), (const bf16*)(ws + WS_WIN) + (size_t)4608 * 1024, T, 1024, 1024, 2048}; pg8::StaticOrder S; S.init(g, F.G, F.c);
          pg8::EpiInProj E{(bf16*)(ws + WS_Q), (bf16*)(ws + WS_K), (bf16*)(ws + WS_V), (bf16*)(ws + WS_XR), (bf16*)(ws + WS_XG), (bf16*)(ws + WS_GA), (bf16*)(ws + WS_GR), 6};
          pg8::gemm_phase<pg8::EpiInProj, pg8::StaticOrder>(F.lds, g, S, E); }
        { pg8::Gemm g{(const bf16*)(ws + WS_PB), (const bf16*)(ws + WS_WPP), T, 1024, PLE, 2 * PLE}; pg8::StaticOrder S; S.init(g, F.G, F.c);
          pg8::EpiF8x8 E{ws + WS_PP, 1024};
          pg8::gemm_phase<pg8::EpiF8x8, pg8::StaticOrder>(F.lds, g, S, E); }
    } SEAM(1);

    if (IN(2)) { p2_qknorm_rope(F); } SEAM(2);

    if (IN(3)) {
        attn::build_rope_table((float*)(F.lds_g + 98304), F.tid);
        __syncthreads();
        for (int L = F.c; L < BATCH * NQH * (SEQ / 256); L += F.G) {
            const int grp = (L >> 8) * 8 + (L & 7), jj = (L & 255) >> 3;
            const int b = grp >> 1, kvh = grp & 1, h = kvh * 4 + (jj & 3), qb = jj >> 2;
            bf16* Qb = (bf16*)(ws + WS_Q) + ((size_t)b * SEQ + qb * 256) * 1024 + h * 128;
            const bf16* Kh = (const bf16*)(ws + WS_K) + (size_t)b * SEQ * 256 + kvh * 128; const bf16* Vh = (const bf16*)(ws + WS_V) + (size_t)b * SEQ * 256 + kvh * 128;
            attn::attn_dense_body(Qb, Kh, Vh, ws + WS_O8 + ((size_t)b * SEQ + qb * 256) * 1024 + h * 128, SEQ, F.lds_g, args.in[I_QN], (const float*)(F.lds_g + 98304), qb * 256);
        }
        STAMP(13);
        for (int u = F.c; u < 256; u += F.G) p3_lru_unit(F, u);
    } SEAM(3);

    if (IN(4)) {
        { pg8::Gemm g{ws + WS_O8, ws + WS_WABR, T, 1024, 1024, 1024}; pg8::StaticOrder S; S.init(g, F.G, F.c);
          pg8::EpiGate<0, true> E{(const bf16*)(ws + WS_GA), nullptr, (bf16*)(ws + WS_U1)};
          pg8::gemm_phase<pg8::EpiGate<0, true>, pg8::StaticOrder, true, true>(F.lds, g, S, E); }
        VM_WAIT(); __syncthreads();
        { pg8::Gemm g{(const bf16*)(ws + WS_XG), (const bf16*)(ws + WS_WLBR), T, 1024, 1024, 2048}; pg8::StaticOrder S; S.init(g, F.G, F.c);
          pg8::EpiGate<1, true, true> E{(const bf16*)(ws + WS_GR), (const bf16*)(ws + WS_U1), (bf16*)(ws + WS_MRG)};
          pg8::gemm_phase<pg8::EpiGate<1, true, true>, pg8::StaticOrder>(F.lds, g, S, E); }
    } SEAM(4);

    if (IN(5)) {
        pg8::Gemm g{ws + WS_MRG, ws + WS_WOUT, T, 1024, 1024, 1024}; pg8::StaticOrder S; S.init(g, F.G, F.c);
        pg8::EpiResid E{args.in[I_X], (bf16*)(ws + WS_H1)};
        pg8::gemm_phase<pg8::EpiResid, pg8::StaticOrder, true, true>(F.lds, g, S, E);
    } SEAM(5);

    if (IN(6)) { p6_router(F); } SEAM(6);

    if (IN(7)) {
        const int ntile = moe_tables(F, TAB);
        pg8::Gemm g{ws + WS_H1F8, ws + WS_WGU, CAP, 2048, 1024, 1024}; pg8::MoeGatherOrder S; S.init_moe(g, ntile, F.G, F.c, TAB + 96, (size_t)2048 * 1024); S.gmap = (LAS int*)(F.lds + LDS_GMAP_OFF);
        moe_prepare(F, S, TAB, (LAS int*)(F.lds + LDS_GMAP_OFF));
        pg8::EpiSwiglu E{TAB + 96, args.in[I_BGU], ws + WS_ACT, (const float*)(ws + WS_SGATE)};
        pg8::gemm_phase<pg8::EpiSwiglu, pg8::MoeGatherOrder, true, true>(F.lds, g, S, E);
    } SEAM(7);

    if (IN(8)) {
        const int ntile = moe_tables(F, TAB);
        pg8::Gemm g{ws + WS_ACT, ws + WS_WDN, CAP, 1024, 1024, 1024}; pg8::MoeOrder S; S.init_moe(g, ntile, F.G, F.c, TAB + 96, (size_t)1024 * 1024);
        pg8::EpiDown E{TAB + 96, args.in[I_BDN], (const u32x2*)(ws + WS_STOK), ws + WS_YK};
        pg8::gemm_phase<pg8::EpiDown, pg8::MoeOrder, true, true>(F.lds, g, S, E);
    } SEAM(8);

    if (IN(9)) { p10_combine(F, TAB); } SEAM(9);

    if (IN(10)) {
        pg8::Gemm g{ws + WS_H1B, ws + WS_WPG, T, 1024, 1024, 1024}; pg8::StaticOrder S; S.init(g, F.G, F.c);
        pg8::EpiPle E{args.out, (const float*)(ws + WS_RSTD2), ws + WS_PP, (const bf16*)(ws + WS_H2H)};
        pg8::gemm_phase<pg8::EpiPle, pg8::StaticOrder, true, true>(F.lds, g, S, E);
    }
#ifdef STAMP_SEL
    xcd_barrier(bar); STAMP(11);
    if (blockIdx.x == 0 && F.tid == 0) {
        const unsigned long long t0 = ((unsigned long long)LCTL[17 + 2 * (STAMP_SEL)] << 32) | LCTL[16 + 2 * (STAMP_SEL)], t1 = ((unsigned long long)LCTL[17 + 2 * (STAMP_SEL2)] << 32) | LCTL[16 + 2 * (STAMP_SEL2)];
        args.out[0] += (float)(t1 - t0) * (0.01f / STAMP_DIV); }
#endif
#undef IN
#undef SEAM
}

extern "C" void kernel_launch(void* const* d_in, const int* in_sizes, int n_in, void* d_out, int out_size, void* d_ws, size_t ws_size, hipStream_t stream) {
    static int grid = 0;
    if (grid == 0) {
        if (n_in != 26 || out_size != T * D_MODEL || ws_size < WS_END) { fprintf(stderr, "kernel_launch: unexpected shapes (n_in %d out %d ws %zu, need ws >= %zu)\n", n_in, out_size, ws_size, (size_t)WS_END); grid = -1; return; }
        int dev = 0, cus = 0, per_cu = 0;
        if (hipGetDevice(&dev) != hipSuccess || hipDeviceGetAttribute(&cus, hipDeviceAttributeMultiprocessorCount, dev) != hipSuccess) { grid = -1; return; }
        if (hipFuncSetAttribute((const void*)mk_fwd, hipFuncAttributeMaxDynamicSharedMemorySize, LDS_BYTES) != hipSuccess) { fprintf(stderr, "kernel_launch: hipFuncSetAttribute failed\n"); grid = -1; return; }
        if (hipOccupancyMaxActiveBlocksPerMultiprocessor(&per_cu, (const void*)mk_fwd, 512, LDS_BYTES) != hipSuccess || per_cu < 1) { fprintf(stderr, "kernel_launch: occupancy query reports %d\n", per_cu); per_cu = 1; }
        (void)hipGetLastError();
        grid = cus;
    }
    if (grid < 0) return;
    (void)hipMemsetAsync((char*)d_ws + WS_CTL, 0, CTL_ZERO_BYTES, stream);
    Args a{};
    for (int i = 0; i < 26; ++i) a.in[i] = (const float*)d_in[i];
    a.out = (float*)d_out; a.ws = (unsigned char*)d_ws; a.pad = 0;
#if MK_N_LAUNCHES == 1
    a.ph_lo = 0; a.ph_hi = NPHASE; a.use_bar = 1;
    hipLaunchKernelGGL(mk_fwd, dim3(grid), dim3(512), LDS_BYTES, stream, a);
#else
    for (int p = 0; p < NPHASE; ++p) { a.ph_lo = p; a.ph_hi = p + 1; a.use_bar = 0; hipLaunchKernelGGL(mk_fwd, dim3(grid), dim3(512), LDS_BYTES, stream, a); }
#endif
}
```
